# Optimizing an MI355X kernel written in HIP

```python
import math
import jax, jax.numpy as jnp
from jax import lax
import numpy as np

D_MODEL = 1024
BATCH = 2
SEQ = 16384
DEPTH = 2
DEC_BATCH = 4
DEC_SEQ = 4096
PAST_LEN = 128

HEAD_DIM = 64
N_HEADS = D_MODEL // HEAD_DIM
N_KV_HEADS = N_HEADS // 4
GROUP = N_HEADS // N_KV_HEADS
ATTN_WIDTH = N_HEADS * HEAD_DIM
KV_WIDTH = N_KV_HEADS * HEAD_DIM
ATTN_IN_WIDTH = 2 * ATTN_WIDTH + 2 * KV_WIDTH
WINDOW = 128
BLOCK = 128
NUM_BUCKETS = 32
MAX_DISTANCE = 128
N_FGROUPS = 4
FGROUP_CH = D_MODEL // N_FGROUPS
FOURIER_WIDTH = D_MODEL
RMS_EPS = 1e-6
N_MIXERS = 2
N_ATTN_LAYERS = (DEPTH + 1) // 2
N_FOURIER_LAYERS = DEPTH // 2

kernel_name = "hybrid_window_gqa_fnet_encoder"


def rmsnorm(x, g):
    xf = x.astype(jnp.float32)
    inv = lax.rsqrt(jnp.mean(xf * xf, axis=-1, keepdims=True) + RMS_EPS)
    return (xf * inv * g.astype(jnp.float32)).astype(x.dtype)


def t5_bucket_np(rel):
    half = NUM_BUCKETS // 2
    n = -rel
    ret = (n < 0).astype(np.int32) * half
    n = np.abs(n)
    max_exact = half // 2
    is_small = n < max_exact
    large = max_exact + (np.log(np.maximum(n, 1) / max_exact) / math.log(MAX_DISTANCE / max_exact)
                         * (half - max_exact)).astype(np.int32)
    large = np.minimum(large, half - 1)
    return (ret + np.where(is_small, n, large)).astype(np.int32)


def band_windows(t, nb):
    b = t.shape[0]
    tp = jnp.pad(t, ((0, 0), (BLOCK, BLOCK), (0, 0), (0, 0)))
    tb = tp.reshape(b, nb + 2, BLOCK, t.shape[2], t.shape[3])
    return jnp.concatenate([tb[:, :-2], tb[:, 1:-1], tb[:, 2:]], axis=2)


def banded_gqa_with_sink(q, k, v, rel_bias, sink):
    b, s = q.shape[0], q.shape[1]
    nb = s // BLOCK
    qb = q.reshape(b, nb, BLOCK, N_KV_HEADS, GROUP, HEAD_DIM)
    kw = band_windows(k, nb)
    vw = band_windows(v, nb)
    qi = np.arange(BLOCK)[:, None]
    kj = np.arange(3 * BLOCK)[None, :]
    rel = kj - BLOCK - qi
    band = np.abs(rel) <= WINDOW
    kpos = (np.arange(nb)[:, None] - 1) * BLOCK + np.arange(3 * BLOCK)[None, :]
    valid = (kpos >= 0) & (kpos < s)
    mask = jnp.asarray(band[None, :, :] & valid[:, None, :])
    bucket = jnp.asarray(t5_bucket_np(rel))
    bias = rel_bias.astype(jnp.float32)[bucket]
    bias = jnp.transpose(bias, (2, 0, 1)).reshape(N_KV_HEADS, GROUP, BLOCK, 3 * BLOCK)
    scale = HEAD_DIM ** -0.5
    scores = jnp.einsum('bnqhgd,bnkhd->bnhgqk', qb, kw).astype(jnp.float32) * scale + bias
    scores = jnp.where(mask[None, :, None, None, :, :], scores, -jnp.inf)
    sk = sink.astype(jnp.float32).reshape(N_KV_HEADS, GROUP)[None, None, :, :, None, None]
    m = jnp.maximum(jnp.max(scores, axis=-1, keepdims=True), sk)
    p = jnp.exp(scores - m)
    denom = jnp.sum(p, axis=-1, keepdims=True) + jnp.exp(sk - m)
    p = p / denom
    o = jnp.einsum('bnhgqk,bnkhd->bnqhgd', p, vw.astype(jnp.float32))
    return o.reshape(b, s, ATTN_WIDTH).astype(q.dtype)


def attention_layer(x, g, w_in, w_out, sink, rel_bias):
    b, s, _ = x.shape
    h = rmsnorm(x, g)
    z = h @ w_in
    q = z[..., :ATTN_WIDTH].reshape(b, s, N_HEADS, HEAD_DIM)
    k = z[..., ATTN_WIDTH:ATTN_WIDTH + KV_WIDTH].reshape(b, s, N_KV_HEADS, HEAD_DIM)
    v = z[..., ATTN_WIDTH + KV_WIDTH:ATTN_WIDTH + 2 * KV_WIDTH].reshape(b, s, N_KV_HEADS, HEAD_DIM)
    gate = z[..., ATTN_WIDTH + 2 * KV_WIDTH:]
    o = banded_gqa_with_sink(q, k, v, rel_bias, sink)
    return x + (o * jax.nn.silu(gate)) @ w_out


def fourier_layer(x, g, w_gate, w_out):
    b, s, d = x.shape
    h = rmsnorm(x, g)
    hg = h.astype(jnp.float32).reshape(b, s, N_FGROUPS, FGROUP_CH)
    f = jnp.fft.fftn(hg, axes=(1, 3), norm="ortho").real
    f = f.reshape(b, s, d).astype(x.dtype)
    gate = h @ w_gate
    return x + (f * jax.nn.silu(gate)) @ w_out


def trunk(x, rel_bias, attn_norm, attn_w_in, attn_w_out, attn_sink,
          fourier_norm, fourier_w_gate, fourier_w_out, final_norm):
    for i in range(DEPTH):
        j = i // N_MIXERS
        if i % N_MIXERS == 0:
            x = attention_layer(x, attn_norm[j], attn_w_in[j], attn_w_out[j], attn_sink[j], rel_bias)
        else:
            x = fourier_layer(x, fourier_norm[j], fourier_w_gate[j], fourier_w_out[j])
    return rmsnorm(x, final_norm)


def setup_inputs(seed: int = 0) -> dict:
    key = jax.random.key(seed)
    ks = jax.random.split(key, 12)
    f32 = jnp.float32
    return {
        "x_prompt": jax.random.normal(ks[0], (BATCH, SEQ, D_MODEL), f32),
        "x_sample": jax.random.normal(ks[1], (DEC_BATCH, DEC_SEQ, D_MODEL), f32),
        "rel_bias": 0.5 * jax.random.normal(ks[2], (NUM_BUCKETS, N_HEADS), f32),
        "attn_norm": 1.0 + 0.02 * jax.random.normal(ks[3], (N_ATTN_LAYERS, D_MODEL), f32),
        "attn_w_in": jax.random.normal(ks[4], (N_ATTN_LAYERS, D_MODEL, ATTN_IN_WIDTH), f32) * D_MODEL ** -0.5,
        "attn_w_out": jax.random.normal(ks[5], (N_ATTN_LAYERS, ATTN_WIDTH, D_MODEL), f32) * ATTN_WIDTH ** -0.5,
        "attn_sink": 0.5 * jax.random.normal(ks[6], (N_ATTN_LAYERS, N_HEADS), f32),
        "fourier_norm": 1.0 + 0.02 * jax.random.normal(ks[7], (N_FOURIER_LAYERS, D_MODEL), f32),
        "fourier_w_gate": jax.random.normal(ks[8], (N_FOURIER_LAYERS, D_MODEL, FOURIER_WIDTH), f32) * D_MODEL ** -0.5,
        "fourier_w_out": jax.random.normal(ks[9], (N_FOURIER_LAYERS, FOURIER_WIDTH, D_MODEL), f32) * FOURIER_WIDTH ** -0.5,
        "final_norm": 1.0 + 0.02 * jax.random.normal(ks[10], (D_MODEL,), f32),
    }


def reference(x_prompt, x_sample, rel_bias, attn_norm, attn_w_in, attn_w_out, attn_sink,
              fourier_norm, fourier_w_gate, fourier_w_out, final_norm):
    y_prompt = trunk(x_prompt, rel_bias, attn_norm, attn_w_in, attn_w_out, attn_sink,
                     fourier_norm, fourier_w_gate, fourier_w_out, final_norm)
    y_sample = trunk(x_sample, rel_bias, attn_norm, attn_w_in, attn_w_out, attn_sink,
                     fourier_norm, fourier_w_gate, fourier_w_out, final_norm)
    return (y_prompt, y_sample)
```

```cpp
#include <hip/hip_runtime.h>
#include <cstdio>
#include <cstdint>

namespace pg8 {
#define PG8_LAS __attribute__((address_space(3)))
typedef unsigned short bf16_t;
typedef short bf16x8 __attribute__((ext_vector_type(8)));
typedef float f32x4 __attribute__((ext_vector_type(4)));
typedef unsigned u32x4 __attribute__((ext_vector_type(4)));
constexpr int BM = 256, BK = 64, HALF = 128, HTB = HALF * BK * 2  , STAGE_BYTES = 8 * HTB, NXCD = 8, WGM = 8;

__host__ __device__ __forceinline__ int lds_byte(int r, int c) { const int st = (r >> 4) * 2 + (c >> 5), rr = r & 15, cc = c & 31, ob = rr * 64 + cc * 2; return st * 1024 + (ob ^ (((ob >> 9) & 1) << 5)); }
__host__ __device__ __forceinline__ void stage_rc(int b, int& R, int& C) { const int st = b / 1024, sb = b % 1024, swz = sb ^ (((sb >> 9) & 1) << 5); R = (st >> 1) * 16 + swz / 64; C = (st & 1) * 32 + (swz % 64) / 2; }
__host__ __device__ __forceinline__ int perm32(int rho) { const int n = rho >> 4, i = rho & 15; return 8 * (i >> 2) + 4 * n + (i & 3); }

struct Unit { int pm, pn; };
struct Gemm { const bf16_t* A; const bf16_t* Bt; int M, N, K, lda, ldb, a_grp; };

struct StaticOrder {
    int nM, nN, nwg, G, c;
    __host__ __device__ void init(int M, int N, int G_, int c_) { nM = M / BM; nN = N / BM; nwg = nM * nN; G = G_; c = c_; }
    __host__ __device__ bool next(int i, Unit& u) const {
        const long L = (long)i * G + c; if (L >= nwg) return false;
        int wgid = (int)L; { const int q = nwg / NXCD, r = nwg % NXCD, xcd = wgid % NXCD, off = wgid / NXCD; wgid = (xcd < r ? xcd * (q + 1) : r * (q + 1) + (xcd - r) * q) + off; }
        const int nig = WGM * nN, gid = wgid / nig, fm = gid * WGM, gsz = (nM - fm) < WGM ? (nM - fm) : WGM;
        u.pm = fm + ((wgid % nig) % gsz); u.pn = (wgid % nig) / gsz; return true;
    }
};

__device__ __forceinline__ unsigned cvt_pk_bf16(float lo, float hi) { unsigned r; asm volatile("v_cvt_pk_bf16_f32 %0, %1, %2" : "=v"(r) : "v"(lo), "v"(hi)); return r; }

template <class Epi, class Sched, bool ALIGN_EPI = false>
__device__ __forceinline__ void gemm_phase(PG8_LAS unsigned char* lds, const Gemm g, const Sched& S, const Epi& E) {
    const int tid = threadIdx.x, wid = __builtin_amdgcn_readfirstlane(tid >> 6), lane = tid & 63, wr = wid >> 2, wc = wid & 3, fr = lane & 15, fq = lane >> 4;
    const int K = g.K, nt = K / BK;
    unsigned voffA[2], voffB[2];
#pragma unroll
    for (int i = 0; i < 2; ++i) { int R, C; stage_rc(tid * 16 + i * 8192, R, C); const int Rb = Epi::PERM ? ((R & ~31) + perm32(R & 31)) : R;
        voffA[i] = (unsigned)(R * g.lda + C) * 2u; voffB[i] = (unsigned)(Rb * g.ldb + C) * 2u; }
    const size_t kstep = (size_t)(BK * 2);
    const size_t hstepA = (size_t)HALF * g.lda * 2, hstepB = (size_t)HALF * g.ldb * 2;
    const size_t tstepA = 2 * hstepA, tstepB = 2 * hstepB;
    const unsigned ldsw = (unsigned)wid * 1024u;
    const int aoff = lds_byte(wr * 64 + fr, fq * 8), boff = lds_byte(wc * 32 + fr, fq * 8);
#define PG8_SA(b, h) (((b) * 2 + (h)) * HTB)
#define PG8_SB(b, h) ((4 + (b) * 2 + (h)) * HTB)
#define PG8_STAGE(bufoff, gbase, voff) do { _Pragma("unroll") for (int _i = 0; _i < 2; ++_i) \
        __builtin_amdgcn_global_load_lds((const unsigned*)((const char*)(gbase) + (voff)[_i]), (PG8_LAS unsigned*)(lds + (bufoff) + ldsw + _i * 8192), 16, 0, 0); } while (0)
#define PG8_LDA(dst, b, h) do { _Pragma("unroll") for (int m = 0; m < 4; ++m) _Pragma("unroll") for (int k = 0; k < 2; ++k) dst[m][k] = *(const PG8_LAS bf16x8*)(lds + PG8_SA(b, h) + aoff + m * 2048 + k * 1024); } while (0)
#define PG8_LDB(dst, b, h) do { _Pragma("unroll") for (int n = 0; n < 2; ++n) _Pragma("unroll") for (int k = 0; k < 2; ++k) dst[n][k] = *(const PG8_LAS bf16x8*)(lds + PG8_SB(b, h) + boff + n * 2048 + k * 1024); } while (0)
#define PG8_MMA(ai, bj, At, Bt) do { __builtin_amdgcn_s_setprio(1); _Pragma("unroll") for (int m = 0; m < 4; ++m) _Pragma("unroll") for (int n = 0; n < 2; ++n) _Pragma("unroll") for (int k = 0; k < 2; ++k) \
        acc[ai][bj][m][n] = __builtin_amdgcn_mfma_f32_16x16x32_bf16(Bt[n][k], At[m][k], acc[ai][bj][m][n], 0, 0, 0); __builtin_amdgcn_s_setprio(0); } while (0)
#define PG8_WAIT_V(n) asm volatile("s_waitcnt vmcnt(" #n ")" ::: "memory")
#define PG8_WAIT_L(n) asm volatile("s_waitcnt lgkmcnt(" #n ")" ::: "memory")
#define PG8_BAR __builtin_amdgcn_s_barrier()
#define PG8_SCHED __builtin_amdgcn_sched_barrier(0)
#define PG8_ABASE(u) ((const char*)g.A + (size_t)(u).pm * tstepA + (g.a_grp ? (size_t)((u).pn / g.a_grp) * (size_t)K * 2 : (size_t)0))
#define PG8_BBASE(u) ((const char*)g.Bt + (size_t)(u).pn * tstepB)
    Unit cur, nxt; int ui = 0;
    if (!S.next(0, cur)) return;
    f32x4 acc[2][2][4][2];
#pragma unroll
    for (int a = 0; a < 2; ++a)
#pragma unroll
        for (int b = 0; b < 2; ++b)
#pragma unroll
            for (int m = 0; m < 4; ++m)
#pragma unroll
                for (int n = 0; n < 2; ++n) acc[a][b][m][n] = (f32x4){0.f, 0.f, 0.f, 0.f};
    bf16x8 At[4][2], B0[2][2], B1[2][2];
    const char* cA = PG8_ABASE(cur); const char* cB = PG8_BBASE(cur);
    PG8_STAGE(PG8_SB(0, 0), cB, voffB); PG8_STAGE(PG8_SB(0, 1), cB + hstepB, voffB); PG8_STAGE(PG8_SA(0, 0), cA, voffA); PG8_STAGE(PG8_SA(0, 1), cA + hstepA, voffA);
    if (wr == 1) PG8_BAR;
    PG8_WAIT_V(2); PG8_BAR;
    PG8_STAGE(PG8_SB(1, 0), cB + kstep, voffB); PG8_STAGE(PG8_SA(1, 0), cA + kstep, voffA); PG8_STAGE(PG8_SB(1, 1), cB + hstepB + kstep, voffB);
    PG8_WAIT_V(6); PG8_BAR;
    for (;;) {
        const bool has_next = S.next(ui + 1, nxt);
        const char* nA = has_next ? PG8_ABASE(nxt) : cA; const char* nB = has_next ? PG8_BBASE(nxt) : cB;
        for (int t = 0; t < nt; t += 2) {
            const bool last = (t == nt - 2);
            const char* a1 = cA + (size_t)(t + 1) * kstep;
            const char* a2 = last ? nA : cA + (size_t)(t + 2) * kstep; const char* b2 = last ? nB : cB + (size_t)(t + 2) * kstep;
            const char* a3 = a2 + kstep; const char* b3 = b2 + kstep;
            PG8_LDB(B0, 0, 0); PG8_LDB(B1, 0, 1); PG8_SCHED; PG8_LDA(At, 0, 0); PG8_STAGE(PG8_SA(1, 1), a1 + hstepA, voffA);
            PG8_WAIT_V(8); PG8_WAIT_L(0); PG8_BAR; PG8_MMA(0, 0, At, B0); PG8_MMA(0, 1, At, B1); PG8_BAR; PG8_SCHED;
            PG8_LDA(At, 0, 1); PG8_STAGE(PG8_SB(0, 0), b2, voffB); PG8_STAGE(PG8_SB(0, 1), b2 + hstepB, voffB); PG8_STAGE(PG8_SA(0, 0), a2, voffA);
            PG8_WAIT_V(8); PG8_WAIT_L(0); PG8_BAR; PG8_MMA(1, 0, At, B0); PG8_MMA(1, 1, At, B1); PG8_BAR; PG8_SCHED;
            PG8_LDB(B0, 1, 0); PG8_LDB(B1, 1, 1); PG8_SCHED; PG8_LDA(At, 1, 0); PG8_STAGE(PG8_SA(0, 1), a2 + hstepA, voffA);
            PG8_WAIT_V(8); PG8_WAIT_L(0); PG8_BAR; PG8_MMA(0, 0, At, B0); PG8_MMA(0, 1, At, B1); PG8_BAR; PG8_SCHED;
            PG8_LDA(At, 1, 1); PG8_STAGE(PG8_SB(1, 0), b3, voffB); PG8_STAGE(PG8_SB(1, 1), b3 + hstepB, voffB); PG8_STAGE(PG8_SA(1, 0), a3, voffA);
            PG8_WAIT_V(8); PG8_WAIT_L(0); PG8_BAR; PG8_MMA(1, 0, At, B0); PG8_MMA(1, 1, At, B1); PG8_BAR; PG8_SCHED;
        }
        if constexpr (ALIGN_EPI) { if (wr == 0) PG8_BAR; }
        E(acc, cur, wr, wc, fr, fq);
        if (!has_next) break;
#pragma unroll
        for (int a = 0; a < 2; ++a)
#pragma unroll
            for (int b = 0; b < 2; ++b)
#pragma unroll
                for (int m = 0; m < 4; ++m)
#pragma unroll
                    for (int n = 0; n < 2; ++n) acc[a][b][m][n] = (f32x4){0.f, 0.f, 0.f, 0.f};
        cur = nxt; cA = nA; cB = nB; ++ui;
        if constexpr (ALIGN_EPI) { if (wr == 1) PG8_BAR; }
    }
    PG8_WAIT_V(0);
    if constexpr (!ALIGN_EPI) { if (wr == 0) PG8_BAR; }
    PG8_BAR;
#undef PG8_SA
#undef PG8_SB
#undef PG8_STAGE
#undef PG8_LDA
#undef PG8_LDB
#undef PG8_MMA
#undef PG8_WAIT_V
#undef PG8_WAIT_L
#undef PG8_BAR
#undef PG8_SCHED
#undef PG8_ABASE
#undef PG8_BBASE
}
}

constexpr int NWAVES = 8, NTHR = 512;
#ifndef MK_ONE_LAUNCH
#define MK_ONE_LAUNCH 1
#endif
constexpr int D = 1024;
constexpr int T_PROMPT = 2 * 16384, T_SAMPLE = 4 * 4096, TT = T_PROMPT + T_SAMPLE;
constexpr int NSEQ = 6;
constexpr int NH = 16, NKV = 4, HD = 64, KVW = 256, INW = 2560;
constexpr float RMS_EPS = 1e-6f;
constexpr float LOG2E = 1.4426950408889634f;
constexpr float QSCALE = 0.125f * LOG2E;
constexpr int N2 = 128;
constexpr int NPH = 9;

__host__ __device__ __forceinline__ int seq_base(int s) { return s < 2 ? s * 16384 : T_PROMPT + (s - 2) * 4096; }
__host__ __device__ __forceinline__ int seq_len(int s) { return s < 2 ? 16384 : 4096; }

constexpr size_t MiB = 1u << 20;
constexpr size_t WS_CTL = 0, CTL_ZERO_BYTES = 1 * MiB;
constexpr size_t WS_WIN = 1 * MiB;
constexpr size_t WS_WO = 6 * MiB;
constexpr size_t WS_WG = 8 * MiB;
constexpr size_t WS_WO2 = 10 * MiB;
constexpr size_t WS_WDFT = 12 * MiB;
constexpr size_t WS_TAB = 13 * MiB;
constexpr size_t TAB_A1P = 0;
constexpr size_t TAB_A1S = 128 * 1024;
constexpr size_t TAB_A2 = 144 * 1024;
constexpr size_t TAB_BIAS = 208 * 1024;
constexpr size_t TAB_INV0 = 256 * 1024;
constexpr size_t WS_SS1 = 14 * MiB;
constexpr size_t WS_SS2 = 17 * MiB;
constexpr size_t WS_ZY = 20 * MiB;
constexpr size_t WS_XB = 20 * MiB;
constexpr size_t WS_K = 116 * MiB;
constexpr size_t WS_V = 140 * MiB;
constexpr size_t WS_Q = 212 * MiB;
constexpr size_t WS_SG = 308 * MiB;
constexpr size_t WS_END = 404 * MiB;
constexpr int CW_BAR = 4096;

constexpr int RING_OFF = 0, RING_BYTES = 131072;
constexpr int LDSCTL_OFF = RING_BYTES, MISC_OFF = LDSCTL_OFF + 320;
constexpr int LDS_BYTES = 147456;

#define GAS __attribute__((address_space(1)))
#define LAS __attribute__((address_space(3)))
typedef unsigned short bf16;
typedef unsigned v4u __attribute__((ext_vector_type(4)));
typedef unsigned v2u __attribute__((ext_vector_type(2)));
typedef float f32x4 __attribute__((ext_vector_type(4)));
typedef GAS unsigned gu32;
#define RLX_AGENT __ATOMIC_RELAXED, __HIP_MEMORY_SCOPE_AGENT
#define LDS_WAIT() asm volatile("s_waitcnt lgkmcnt(0)" ::: "memory")
#define VM_WAIT() asm volatile("s_waitcnt vmcnt(0)" ::: "memory")
__device__ __forceinline__ unsigned f2bf(float f) { unsigned u = __builtin_bit_cast(unsigned, f); return (u + 0x7fffu + ((u >> 16) & 1u)) >> 16; }
__device__ __forceinline__ unsigned pk2(float lo, float hi) { return f2bf(lo) | (f2bf(hi) << 16); }
__device__ __forceinline__ float bf2f(unsigned short b) { return __builtin_bit_cast(float, (unsigned)b << 16); }
__device__ __forceinline__ float bflo(unsigned w) { return __builtin_bit_cast(float, w << 16); }
__device__ __forceinline__ float bfhi(unsigned w) { return __builtin_bit_cast(float, w & 0xffff0000u); }
__device__ __forceinline__ float silu_f(float x) { return x * __builtin_amdgcn_rcpf(1.0f + __builtin_amdgcn_exp2f(-x * LOG2E)); }

#define XB_TMO      128
#define XB_XCNT(j)  (256  + 64 * (j))
#define XB_XSUB(j)  (1280 + 64 * (j))
#define XB_XGEN(j)  (2304 + 64 * (j))
#define XB_TOP      3328
#define XB_TOPGEN   3392
#define XCD_BAR_WORDS 3456
#define XB_SPIN_CAP (1u << 18)
__device__ __forceinline__ unsigned xb_ld(unsigned* p)              { return __hip_atomic_load(p, __ATOMIC_RELAXED, __HIP_MEMORY_SCOPE_AGENT); }
__device__ __forceinline__ unsigned xb_add(unsigned* p, unsigned v) { return __hip_atomic_fetch_add(p, v, __ATOMIC_RELAXED, __HIP_MEMORY_SCOPE_AGENT); }
__device__ __forceinline__ unsigned xb_xcc_id() { return (unsigned)__builtin_amdgcn_s_getreg((3 << 11) | 20) & 0xFu; }
#define XB_SPIN(cond, bar) do { unsigned _sp = 0; while (cond) { __builtin_amdgcn_s_sleep(1); \
    if ((++_sp & 255u) == 0u) { if (xb_ld(&(bar)[XB_TMO])) break; if (_sp > XB_SPIN_CAP) { atomicAdd(&(bar)[XB_TMO], 1u); break; } } } } while (0)
struct XcdBarrier { unsigned* bar; unsigned x; volatile LAS unsigned* st; };
__device__ __forceinline__ XcdBarrier xcd_barrier_post(unsigned* bar, volatile LAS unsigned* st) {
    XcdBarrier b; b.bar = bar; b.x = xb_xcc_id(); b.st = st;
    if (threadIdx.x == 0) (void)xb_add(&bar[XB_XCNT(b.x)], 1u);
    return b;
}
__device__ __forceinline__ void xcd_barrier_complete(unsigned* bar, unsigned x, unsigned& nloc, unsigned& nx) {
    const unsigned G = gridDim.x * gridDim.y * gridDim.z;
    unsigned sum, cnt, mine, sp = 0u;
    for (;;) {
        sum = 0u; cnt = 0u; mine = 0u;
#pragma unroll
        for (unsigned j = 0; j < 16; ++j) { const unsigned c = xb_ld(&bar[XB_XCNT(j)]); sum += c; cnt += (c > 0u) ? 1u : 0u; mine = (j == x) ? c : mine; }
        if (sum == G) break;
        __builtin_amdgcn_s_sleep(1);
        if ((++sp & 255u) == 0u) { if (xb_ld(&bar[XB_TMO])) break; if (sp > XB_SPIN_CAP) { atomicAdd(&bar[XB_TMO], 1u); break; } }
    }
    nloc = mine > 0u ? mine : 1u; nx = cnt > 0u ? cnt : 1u;
}
__device__ __forceinline__ void xcd_barrier(const XcdBarrier& b) {
    asm volatile("s_waitcnt vmcnt(0)" ::: "memory");
    __syncthreads();
    if (threadIdx.x == 0) {
        unsigned* bar = b.bar;
        __builtin_amdgcn_s_waitcnt(0);
        unsigned nloc = b.st[0], nx = b.st[1];
        if (nloc == 0u) { xcd_barrier_complete(bar, b.x, nloc, nx); b.st[0] = nloc; b.st[1] = nx; }
        const unsigned old = xb_add(&bar[XB_XSUB(b.x)], 1u);
        const unsigned gen = old / nloc;
        if (old + 1u == (gen + 1u) * nloc) {
            __builtin_amdgcn_fence(__ATOMIC_RELEASE, "agent");
            asm volatile("s_waitcnt vmcnt(0)" ::: "memory");
            const unsigned og = xb_add(&bar[XB_TOP], 1u);
            const unsigned tg = og / nx;
            if (og + 1u == (tg + 1u) * nx) xb_add(&bar[XB_TOPGEN], 1u);
            else XB_SPIN(xb_ld(&bar[XB_TOPGEN]) == tg, bar);
            __builtin_amdgcn_fence(__ATOMIC_ACQUIRE, "agent");
            xb_add(&bar[XB_XGEN(b.x)], 1u);
            asm volatile("s_waitcnt vmcnt(0)" ::: "memory");
        } else {
            XB_SPIN(xb_ld(&bar[XB_XGEN(b.x)]) == gen, bar);
            __builtin_amdgcn_fence(__ATOMIC_ACQUIRE, "agent");
            asm volatile("s_waitcnt vmcnt(0)" ::: "memory");
        }
    }
    __syncthreads();
}

struct Frame {
    LAS unsigned char* lds;
    volatile LAS unsigned* MISC;
    gu32* ctl;
    int tid, lane, wave, vcu, G;
    const float *xp, *xs, *relb, *g1, *win, *wo, *sink, *g2, *wg, *wo2, *gf;
    float* out;
    unsigned char* ws;
};
__device__ __forceinline__ const float* xin_row(const Frame& F, int row) { return row < T_PROMPT ? F.xp + (size_t)row * D : F.xs + (size_t)(row - T_PROMPT) * D; }
__device__ __forceinline__ float wave_sum(float v) {
#pragma unroll
    for (int o = 1; o < 64; o <<= 1) v += __shfl_xor(v, o);
    return v;
}

__device__ __forceinline__ void p0_transpose_item(const float* W, const float* gain, int K, int N, bf16* WT, LAS float* scr, int item, int lane) {
    const int nblk = N / 32, kb = item / nblk, nb = item % nblk, k0 = 64 * kb, n0 = 32 * nb;
#pragma unroll 8
    for (int i = 0; i < 32; ++i) { const int kk = 2 * i + (lane >> 5); const float gv = gain ? gain[k0 + kk] : 1.0f; scr[kk * 33 + (lane & 31)] = gv * W[(size_t)(k0 + kk) * N + n0 + (lane & 31)]; }
    LDS_WAIT(); asm volatile("" ::: "memory");
    const int c = lane & 7;
#pragma unroll
    for (int j = 0; j < 4; ++j) { const int n = (lane >> 3) + 8 * j; const LAS float* s = scr + (8 * c) * 33 + n;
        v4u o; o.x = pk2(s[0 * 33], s[1 * 33]); o.y = pk2(s[2 * 33], s[3 * 33]); o.z = pk2(s[4 * 33], s[5 * 33]); o.w = pk2(s[6 * 33], s[7 * 33]);
        *(GAS v4u*)(WT + (size_t)(n0 + n) * K + k0 + 8 * c) = o; }
    LDS_WAIT(); asm volatile("" ::: "memory");
}
__host__ __device__ __forceinline__ void m_to_k1part(int m, int& k1, int& part) { const int w = m >> 5, j = m & 31; part = (j >> 3) & 1; k1 = 16 * w + (j & 7) + 8 * (j >> 4); }
__host__ __device__ __forceinline__ int t5_bucket(int rel) {
    const int n = -rel; const int a = n < 0 ? -n : n;
    const int b = a < 8 ? a : (a < 12 ? 8 : a < 16 ? 9 : a < 23 ? 10 : a < 32 ? 11 : a < 46 ? 12 : a < 64 ? 13 : a < 91 ? 14 : 15);
    return (n < 0 ? 16 : 0) + b;
}
__device__ __forceinline__ void p0_prologue(Frame& F) {
    LAS float* scr = (LAS float*)(F.lds + RING_OFF + F.wave * 16384);
    const int gw = F.vcu * NWAVES + F.wave, NGW = F.G * NWAVES;
    constexpr int I_IN = (D / 64) * (INW / 32), I_SQ = (D / 64) * (D / 32);
    constexpr int NITEMS = I_IN + 3 * I_SQ;
    bf16* win_t = (bf16*)(F.ws + WS_WIN); bf16* wo_t = (bf16*)(F.ws + WS_WO); bf16* wg_t = (bf16*)(F.ws + WS_WG); bf16* wo2_t = (bf16*)(F.ws + WS_WO2);
    for (int it = gw; it < NITEMS; it += NGW) {
        int r = it;
        if (r < I_IN) { p0_transpose_item(F.win, F.g1, D, INW, win_t, scr, r, F.lane); continue; } r -= I_IN;
        if (r < I_SQ) { p0_transpose_item(F.wo, nullptr, D, D, wo_t, scr, r, F.lane); continue; } r -= I_SQ;
        if (r < I_SQ) { p0_transpose_item(F.wg, F.g2, D, D, wg_t, scr, r, F.lane); continue; } r -= I_SQ;
        p0_transpose_item(F.wo2, nullptr, D, D, wo2_t, scr, r, F.lane);
    }
    const int gt = (F.vcu * NTHR) + F.tid, NGT = F.G * NTHR;
    bf16* wdft = (bf16*)(F.ws + WS_WDFT);
    for (int e = gt; e < 2048 * 256; e += NGT) {
        const int np = e >> 8, c = e & 255, g = np >> 9, ri = (np >> 8) & 1, cp = np & 255;
        const int t = (c * cp) & 255; float sn, cs; sincospif((float)t * (1.0f / 128.0f), &sn, &cs);
        const float v = F.g2[g * 256 + c] * (ri ? -sn : cs) * (1.0f / 16.0f);
        wdft[e] = (bf16)f2bf(v);
    }
    bf16* a1p = (bf16*)(F.ws + WS_TAB + TAB_A1P);
    for (int e = gt; e < 256 * 256; e += NGT) {
        const int m = e >> 8, k = e & 255, ri = k >> 7, s1 = k & 127; int k1, part; m_to_k1part(m, k1, part);
        const int t = (s1 * k1) & 127; float sn, cs; sincospif((float)t * (1.0f / 64.0f), &sn, &cs);
        const float v = (part == 0 ? (ri == 0 ? cs : sn) : (ri == 0 ? -sn : cs)) * 0.08838834764831845f;
        a1p[e] = (bf16)f2bf(v);
    }
    bf16* a1s = (bf16*)(F.ws + WS_TAB + TAB_A1S);
    for (int e = gt; e < 64 * 64; e += NGT) {
        const int m = e >> 6, k = e & 63, ri = k >> 5, s1 = k & 31; int k1, part; m_to_k1part(m, k1, part);
        const int t = (s1 * k1) & 31; float sn, cs; sincospif((float)t * (1.0f / 16.0f), &sn, &cs);
        const float v = (part == 0 ? (ri == 0 ? cs : sn) : (ri == 0 ? -sn : cs)) * 0.17677669529663687f;
        a1s[e] = (bf16)f2bf(v);
    }
    bf16* a2 = (bf16*)(F.ws + WS_TAB + TAB_A2);
    for (int e = gt; e < 128 * 256; e += NGT) {
        const int k2 = e >> 8, k = e & 255, ri = k >> 7, s2 = k & 127;
        const int t = (s2 * k2) & 127; float sn, cs; sincospif((float)t * (1.0f / 64.0f), &sn, &cs);
        a2[e] = (bf16)f2bf((ri == 0 ? cs : sn) * 0.08838834764831845f);
    }
    float* biasT = (float*)(F.ws + WS_TAB + TAB_BIAS);
    for (int e = gt; e < 16 * 272 + 16; e += NGT) {
        if (e < 16 * 272) { const int h = e / 272, r = e % 272; const int rel = (r > 256 ? 256 : r) - 128; biasT[e] = F.relb[t5_bucket(rel) * NH + h] * LOG2E; }
        else biasT[e] = F.sink[e - 16 * 272] * LOG2E;
    }
    bf16* xb = (bf16*)(F.ws + WS_XB); float* inv0 = (float*)(F.ws + WS_TAB + TAB_INV0);
    for (int m = gw; m < TT; m += NGW) {
        const GAS f32x4* xr = (const GAS f32x4*)xin_row(F, m) + F.lane;
        f32x4 v[4]; float s = 0.f;
#pragma unroll
        for (int j = 0; j < 4; ++j) { v[j] = xr[64 * j]; s += (v[j].x * v[j].x + v[j].y * v[j].y) + (v[j].z * v[j].z + v[j].w * v[j].w); }
        s = wave_sum(s);
        if (F.lane == 0) inv0[m] = 1.0f / sqrtf(s * (1.0f / D) + RMS_EPS);
        GAS v2u* o8 = (GAS v2u*)(xb + (size_t)m * D) + F.lane;
#pragma unroll
        for (int j = 0; j < 4; ++j) { v2u w; w.x = pk2(v[j].x, v[j].y); w.y = pk2(v[j].z, v[j].w); o8[64 * j] = w; }
    }
}

using pg8::cvt_pk_bf16;
typedef pg8::f32x4 accv;
#define EPI_ROW(u, ai, m) ((u).pm * 256 + (ai) * 128 + wr * 64 + (m) * 16 + fr)
#define EPI_COL(bj) ((bj) * 128 + wc * 32 + 8 * fq)
__device__ __forceinline__ v4u pack8(accv a, accv b) { v4u w; w.x = cvt_pk_bf16(a[0], a[1]); w.y = cvt_pk_bf16(a[2], a[3]); w.z = cvt_pk_bf16(b[0], b[1]); w.w = cvt_pk_bf16(b[2], b[3]); return w; }
__device__ __forceinline__ accv silu4(accv v) { accv o; o[0] = silu_f(v[0]); o[1] = silu_f(v[1]); o[2] = silu_f(v[2]); o[3] = silu_f(v[3]); return o; }

struct EpiInProj {
    static constexpr bool PERM = true;
    bf16 *Q, *Kb, *Vb, *SG; const float* inv0;
    __device__ __forceinline__ void operator()(const accv (&acc)[2][2][4][2], const pg8::Unit& u, int wr, int wc, int fr, int fq) const {
        const int pn = u.pn;
#pragma unroll
        for (int ai = 0; ai < 2; ++ai)
#pragma unroll
            for (int m = 0; m < 4; ++m) {
                const int row = EPI_ROW(u, ai, m); const float inv = inv0[row];
#pragma unroll
                for (int bj = 0; bj < 2; ++bj) {
                    accv v0 = acc[ai][bj][m][0] * inv, v1 = acc[ai][bj][m][1] * inv; const int col = EPI_COL(bj);
                    if (pn < 4) { v0 = v0 * QSCALE; v1 = v1 * QSCALE; *(v4u*)(Q + (size_t)row * D + pn * 256 + col) = pack8(v0, v1); }
                    else if (pn == 4) { *(v4u*)(Kb + (size_t)row * KVW + col) = pack8(v0, v1); }
                    else if (pn == 5) { *(v4u*)(Vb + (size_t)row * KVW + col) = pack8(v0, v1); }
                    else { *(v4u*)(SG + (size_t)row * D + (pn - 6) * 256 + col) = pack8(silu4(v0), silu4(v1)); }
                }
            }
    }
};
struct EpiResid {
    static constexpr bool PERM = true;
    const float* xp; const float* xs; int in_place; float* out; bf16* xb; float* ss;
    __device__ __forceinline__ void operator()(const accv (&acc)[2][2][4][2], const pg8::Unit& u, int wr, int wc, int fr, int fq) const {
        const int pn = u.pn;
#pragma unroll
        for (int ai = 0; ai < 2; ++ai)
#pragma unroll
            for (int m = 0; m < 4; ++m) {
                const int row = EPI_ROW(u, ai, m);
                const float* src = in_place ? (const float*)out + (size_t)row * D : (row < T_PROMPT ? xp + (size_t)row * D : xs + (size_t)(row - T_PROMPT) * D);
                float q = 0.f;
#pragma unroll
                for (int bj = 0; bj < 2; ++bj) {
                    const int col = pn * 256 + EPI_COL(bj);
                    const accv r0 = *(const accv*)(src + col), r1 = *(const accv*)(src + col + 4);
                    const accv v0 = acc[ai][bj][m][0] + r0, v1 = acc[ai][bj][m][1] + r1;
                    q += (v0[0] * v0[0] + v0[1] * v0[1]) + (v0[2] * v0[2] + v0[3] * v0[3]) + (v1[0] * v1[0] + v1[1] * v1[1]) + (v1[2] * v1[2] + v1[3] * v1[3]);
                    *(accv*)(out + (size_t)row * D + col) = v0; *(accv*)(out + (size_t)row * D + col + 4) = v1;
                    if (xb) *(v4u*)(xb + (size_t)row * D + col) = pack8(v0, v1);
                }
                q += __shfl_xor(q, 16); q += __shfl_xor(q, 32);
                if (fq == 0) ss[(size_t)row * 16 + pn * 4 + wc] = q;
            }
    }
};
__device__ __forceinline__ float inv_from_ss(const float* ss, int row, int fq) {
    const accv p = *(const accv*)(ss + (size_t)row * 16 + fq * 4);
    float s = (p[0] + p[1]) + (p[2] + p[3]); s += __shfl_xor(s, 16); s += __shfl_xor(s, 32);
    return 1.0f / sqrtf(s * (1.0f / D) + RMS_EPS);
}
struct EpiGate2 {
    static constexpr bool PERM = true;
    bf16* SG; const float* ss;
    __device__ __forceinline__ void operator()(const accv (&acc)[2][2][4][2], const pg8::Unit& u, int wr, int wc, int fr, int fq) const {
#pragma unroll
        for (int ai = 0; ai < 2; ++ai)
#pragma unroll
            for (int m = 0; m < 4; ++m) {
                const int row = EPI_ROW(u, ai, m); const float inv = inv_from_ss(ss, row, fq);
#pragma unroll
                for (int bj = 0; bj < 2; ++bj) { const accv v0 = acc[ai][bj][m][0] * inv, v1 = acc[ai][bj][m][1] * inv;
                    *(v4u*)(SG + (size_t)row * D + u.pn * 256 + EPI_COL(bj)) = pack8(silu4(v0), silu4(v1)); }
            }
    }
};
struct EpiChanDft {
    static constexpr bool PERM = true;
    bf16* Z; const float* ss;
    __device__ __forceinline__ void operator()(const accv (&acc)[2][2][4][2], const pg8::Unit& u, int wr, int wc, int fr, int fq) const {
        const int g = u.pn >> 1, ri = u.pn & 1;
#pragma unroll
        for (int ai = 0; ai < 2; ++ai)
#pragma unroll
            for (int m = 0; m < 4; ++m) {
                const int row = EPI_ROW(u, ai, m); const float inv = inv_from_ss(ss, row, fq);
#pragma unroll
                for (int bj = 0; bj < 2; ++bj) { const accv v0 = acc[ai][bj][m][0] * inv, v1 = acc[ai][bj][m][1] * inv;
                    *(v4u*)(Z + (size_t)row * 2048 + ri * 1024 + g * 256 + EPI_COL(bj)) = pack8(v0, v1); }
            }
    }
};

constexpr int ATT_KROW = 66;
__device__ __forceinline__ void attn_naive(Frame& F) {
    const bf16* Q = (const bf16*)(F.ws + WS_Q); const bf16* Kb = (const bf16*)(F.ws + WS_K); const bf16* Vb = (const bf16*)(F.ws + WS_V);
    const bf16* SG = (const bf16*)(F.ws + WS_SG); bf16* OG = (bf16*)(F.ws + WS_XB);
    const float* biasT = (const float*)(F.ws + WS_TAB + TAB_BIAS);
    LAS unsigned short* Kl = (LAS unsigned short*)(F.lds); LAS unsigned short* Vl = Kl + 384 * ATT_KROW;
    const int nunits = (TT / 128) * NKV;
    for (int un = F.vcu; un < nunits; un += F.G) {
        const int blk = un >> 2, kvh = un & 3; const int row0 = blk * 128;
        int sq = 0; for (int s = 0; s < NSEQ; ++s) if (row0 >= seq_base(s)) sq = s;
        const int sb = seq_base(sq), sl = seq_len(sq), p0 = row0 - sb;
        __syncthreads();
        for (int e = F.tid; e < 384 * 8; e += NTHR) {
            const int j = e >> 3, c = e & 7; const int pos = p0 - 128 + j;
            v4u kv = (v4u){0u, 0u, 0u, 0u}, vv = kv;
            if (pos >= 0 && pos < sl) { kv = *(const v4u*)(Kb + (size_t)(sb + pos) * KVW + kvh * 64 + c * 8); vv = *(const v4u*)(Vb + (size_t)(sb + pos) * KVW + kvh * 64 + c * 8); }
            LAS unsigned* kd = (LAS unsigned*)(Kl + j * ATT_KROW + c * 8); kd[0] = kv.x; kd[1] = kv.y; kd[2] = kv.z; kd[3] = kv.w;
            LAS unsigned* vd = (LAS unsigned*)(Vl + j * ATT_KROW + c * 8); vd[0] = vv.x; vd[1] = vv.y; vd[2] = vv.z; vd[3] = vv.w;
        }
        __syncthreads();
        const int hl = F.tid >> 7, ql = F.tid & 127, h = kvh * 4 + hl, row = row0 + ql, pos = p0 + ql;
        float qv[64];
#pragma unroll
        for (int c = 0; c < 8; ++c) { const v4u w = *(const v4u*)(Q + (size_t)row * D + h * 64 + c * 8);
            qv[c * 8 + 0] = bflo(w.x); qv[c * 8 + 1] = bfhi(w.x); qv[c * 8 + 2] = bflo(w.y); qv[c * 8 + 3] = bfhi(w.y); qv[c * 8 + 4] = bflo(w.z); qv[c * 8 + 5] = bfhi(w.z); qv[c * 8 + 6] = bflo(w.w); qv[c * 8 + 7] = bfhi(w.w); }
        float mx = biasT[16 * 272 + h], l = 1.0f; float o[64];
#pragma unroll
        for (int d = 0; d < 64; ++d) o[d] = 0.f;
        for (int rel = -128; rel <= 128; ++rel) {
            const int kp = pos + rel; if (kp < 0 || kp >= sl) continue;
            const int j = ql + rel + 128;
            const LAS unsigned* kr = (const LAS unsigned*)(Kl + j * ATT_KROW);
            float s = 0.f;
#pragma unroll
            for (int c = 0; c < 32; ++c) { const unsigned w = kr[c]; s += qv[2 * c] * bflo(w) + qv[2 * c + 1] * bfhi(w); }
            s += biasT[h * 272 + rel + 128];
            const float mn = fmaxf(mx, s), sc = __builtin_amdgcn_exp2f(mx - mn), p = __builtin_amdgcn_exp2f(s - mn);
            l = l * sc + p; mx = mn;
            const LAS unsigned* vr = (const LAS unsigned*)(Vl + j * ATT_KROW);
#pragma unroll
            for (int c = 0; c < 32; ++c) { const unsigned w = vr[c]; o[2 * c] = o[2 * c] * sc + p * bflo(w); o[2 * c + 1] = o[2 * c + 1] * sc + p * bfhi(w); }
        }
        const float il = 1.0f / l;
#pragma unroll
        for (int c = 0; c < 8; ++c) { const v4u g = *(const v4u*)(SG + (size_t)row * D + h * 64 + c * 8); v4u w;
            w.x = pk2(o[c * 8 + 0] * il * bflo(g.x), o[c * 8 + 1] * il * bfhi(g.x)); w.y = pk2(o[c * 8 + 2] * il * bflo(g.y), o[c * 8 + 3] * il * bfhi(g.y));
            w.z = pk2(o[c * 8 + 4] * il * bflo(g.z), o[c * 8 + 5] * il * bfhi(g.z)); w.w = pk2(o[c * 8 + 6] * il * bflo(g.w), o[c * 8 + 7] * il * bfhi(g.w));
            *(v4u*)(OG + (size_t)row * D + h * 64 + c * 8) = w; }
    }
}

template <int NS, int MROWS>
__device__ __forceinline__ void dft_tile_naive(Frame& F, const bf16* A, const bf16* ZY, size_t rowbase, size_t rstride, int cb, float (&acc)[MROWS / 8]) {
    constexpr int KK = 2 * NS, MPT = MROWS / 8;
    LAS float* Bl = (LAS float*)(F.lds);
    __syncthreads();
    for (int e = F.tid; e < KK * 8; e += NTHR) {
        const int k = e >> 3, c = e & 7, ri = k / NS, s = k % NS;
        const v4u w = *(const v4u*)(ZY + (rowbase + (size_t)s * rstride) * 2048 + ri * 1024 + cb * 64 + c * 8);
        LAS float* d = Bl + k * 64 + c * 8;
        d[0] = bflo(w.x); d[1] = bfhi(w.x); d[2] = bflo(w.y); d[3] = bfhi(w.y); d[4] = bflo(w.z); d[5] = bfhi(w.z); d[6] = bflo(w.w); d[7] = bfhi(w.w);
    }
    __syncthreads();
    const int n = F.tid & 63, mg = __builtin_amdgcn_readfirstlane(F.tid >> 6);
#pragma unroll
    for (int i = 0; i < MPT; ++i) acc[i] = 0.f;
    for (int k = 0; k < KK; ++k) {
        const float b = Bl[k * 64 + n];
#pragma unroll
        for (int i = 0; i < MPT; ++i) acc[i] += bf2f(A[(mg * MPT + i) * KK + k]) * b;
    }
    __syncthreads();
}
__device__ __forceinline__ void stage1_naive(Frame& F) {
    bf16* ZY = (bf16*)(F.ws + WS_ZY);
    const bf16* a1p = (const bf16*)(F.ws + WS_TAB + TAB_A1P); const bf16* a1s = (const bf16*)(F.ws + WS_TAB + TAB_A1S);
    const int NU = 4096 + 8192;
    for (int un = F.vcu; un < NU; un += F.G) {
        const int n = F.tid & 63, mg = F.tid >> 6;
        if (un < 4096) {
            const int sq = un >> 11, s2 = (un >> 4) & 127, cb = un & 15; const size_t base = (size_t)seq_base(sq);
            float acc[32];
            dft_tile_naive<128, 256>(F, a1p, ZY, base + s2, 128, cb, acc);
#pragma unroll
            for (int i = 0; i < 32; ++i) if (((i >> 3) & 1) == 0) {
                const int k1 = 16 * mg + (i & 7) + 8 * (i >> 4); const float yr = acc[i], yi = acc[i + 8];
                const int t = (k1 * s2) & 16383; float sn, cs; sincospif((float)t * (1.0f / 8192.0f), &sn, &cs);
                const size_t orow = base + (size_t)k1 * 128 + s2;
                ZY[orow * 2048 + cb * 64 + n] = (bf16)f2bf(yr * cs + yi * sn);
                ZY[orow * 2048 + 1024 + cb * 64 + n] = (bf16)f2bf(yi * cs - yr * sn);
            }
        } else {
            const int v = un - 4096; const int sq = 2 + (v >> 11), s2 = (v >> 4) & 127, cb = v & 15; const size_t base = (size_t)seq_base(sq);
            float acc[8];
            dft_tile_naive<32, 64>(F, a1s, ZY, base + s2, 128, cb, acc);
            const int m0 = mg * 8; const int w = m0 >> 5, j0 = m0 & 31;
            const int part = (j0 >> 3) & 1;
            LAS float* X = (LAS float*)(F.lds);
#pragma unroll
            for (int i = 0; i < 8; ++i) X[(m0 + i) * 64 + n] = acc[i];
            __syncthreads();
            if (part == 0) {
#pragma unroll
                for (int i = 0; i < 8; ++i) {
                    const int k1 = 16 * w + i + 8 * (j0 >> 4); const float yr = acc[i], yi = X[(m0 + 8 + i) * 64 + n];
                    const int t = (k1 * s2) & 4095; float sn, cs; sincospif((float)t * (1.0f / 2048.0f), &sn, &cs);
                    const size_t orow = base + (size_t)k1 * 128 + s2;
                    ZY[orow * 2048 + cb * 64 + n] = (bf16)f2bf(yr * cs + yi * sn);
                    ZY[orow * 2048 + 1024 + cb * 64 + n] = (bf16)f2bf(yi * cs - yr * sn);
                }
            }
            __syncthreads();
        }
    }
}
__device__ __forceinline__ void stage2_naive(Frame& F) {
    const bf16* ZY = (const bf16*)(F.ws + WS_ZY); const bf16* a2 = (const bf16*)(F.ws + WS_TAB + TAB_A2);
    const bf16* SG = (const bf16*)(F.ws + WS_SG); bf16* U = (bf16*)(F.ws + WS_Q);
    const int NU = 4096 + 2048;
    for (int un = F.vcu; un < NU; un += F.G) {
        int sq, k1, cb, n1;
        if (un < 4096) { sq = un >> 11; k1 = (un >> 4) & 127; cb = un & 15; n1 = 128; }
        else { const int v = un - 4096; sq = 2 + (v >> 9); k1 = (v >> 4) & 31; cb = v & 15; n1 = 32; }
        const size_t base = (size_t)seq_base(sq);
        float acc[16];
        dft_tile_naive<128, 128>(F, a2, ZY, base + (size_t)k1 * 128, 1, cb, acc);
        const int n = F.tid & 63, mg = F.tid >> 6;
#pragma unroll
        for (int i = 0; i < 16; ++i) {
            const int k2 = mg * 16 + i; const size_t tok = base + k1 + (size_t)n1 * k2;
            const float g = bf2f(SG[tok * D + cb * 64 + n]);
            U[tok * D + cb * 64 + n] = (bf16)f2bf(acc[i] * g);
        }
    }
}

__device__ __forceinline__ void final_norm(Frame& F) {
    const float* ss = (const float*)(F.ws + WS_SS2);
    const int gw = F.vcu * NWAVES + F.wave, NGW = F.G * NWAVES;
    for (int m = gw; m < TT; m += NGW) {
        float s = F.lane < 16 ? ss[(size_t)m * 16 + F.lane] : 0.f; s = wave_sum(s);
        const float inv = 1.0f / sqrtf(s * (1.0f / D) + RMS_EPS);
        GAS f32x4* xr = (GAS f32x4*)(F.out + (size_t)m * D) + F.lane; const GAS f32x4* gr = (const GAS f32x4*)F.gf + F.lane;
#pragma unroll
        for (int j = 0; j < 4; ++j) { const f32x4 v = xr[64 * j], g = gr[64 * j]; xr[64 * j] = v * inv * g; }
    }
}

struct Args { const float* in[11]; float* out; unsigned char* ws; int ph_lo, ph_hi; };
__global__ void __launch_bounds__(NTHR, 2) mk_fwd(Args args) {
    extern __shared__ __attribute__((aligned(16))) unsigned char lds[];
    Frame F;
    F.lds = (LAS unsigned char*)lds;
    F.MISC = (volatile LAS unsigned*)(F.lds + MISC_OFF);
    F.tid = threadIdx.x; F.lane = F.tid & 63; F.wave = __builtin_amdgcn_readfirstlane(F.tid >> 6);
    F.G = gridDim.x; { const int bx = blockIdx.x; F.vcu = (F.G % 8 == 0) ? (bx % 8) * (F.G / 8) + bx / 8 : bx; }
    F.ws = args.ws; F.ctl = (gu32*)(args.ws + WS_CTL); F.out = args.out;
    F.xp = args.in[0]; F.xs = args.in[1]; F.relb = args.in[2]; F.g1 = args.in[3]; F.win = args.in[4]; F.wo = args.in[5]; F.sink = args.in[6];
    F.g2 = args.in[7]; F.wg = args.in[8]; F.wo2 = args.in[9]; F.gf = args.in[10];
    for (int u = F.tid; u < (LDS_BYTES - LDSCTL_OFF) / 4; u += NTHR) ((LAS unsigned*)(F.lds + LDSCTL_OFF))[u] = 0u;
    __syncthreads();
    const int lo = args.ph_lo, hi = args.ph_hi;
    XcdBarrier bar; bar.bar = (unsigned*)(F.ctl + CW_BAR); bar.x = 0; bar.st = nullptr;
    if (hi - lo > 1) bar = xcd_barrier_post((unsigned*)(F.ctl + CW_BAR), F.MISC + 8);
#define IN(k) (lo <= (k) && (k) < hi)
#define SEAM(k) do { if (IN(k) && IN((k) + 1)) xcd_barrier(bar); } while (0)
    unsigned char* ws = args.ws;
    bf16* XB = (bf16*)(ws + WS_XB); bf16* Qb = (bf16*)(ws + WS_Q); bf16* Kb = (bf16*)(ws + WS_K); bf16* Vb = (bf16*)(ws + WS_V); bf16* SG = (bf16*)(ws + WS_SG);
    bf16* ZY = (bf16*)(ws + WS_ZY);
    float* inv0 = (float*)(ws + WS_TAB + TAB_INV0); float* ss1 = (float*)(ws + WS_SS1); float* ss2 = (float*)(ws + WS_SS2);

    if (IN(0)) { p0_prologue(F); } SEAM(0);
    if (IN(1)) {
        pg8::Gemm g{XB, (const bf16*)(ws + WS_WIN), TT, INW, D, D, D, 0}; pg8::StaticOrder S; S.init(TT, INW, F.G, (int)blockIdx.x);
        EpiInProj E{Qb, Kb, Vb, SG, inv0};
        pg8::gemm_phase<EpiInProj, pg8::StaticOrder, true>(F.lds + RING_OFF, g, S, E);
    } SEAM(1);
    if (IN(2)) { attn_naive(F); } SEAM(2);
    if (IN(3)) {
        pg8::Gemm g{XB, (const bf16*)(ws + WS_WO), TT, D, D, D, D, 0}; pg8::StaticOrder S; S.init(TT, D, F.G, (int)blockIdx.x);
        EpiResid E{F.xp, F.xs, 0, F.out, Qb, ss1};
        pg8::gemm_phase<EpiResid, pg8::StaticOrder, true>(F.lds + RING_OFF, g, S, E);
    } SEAM(3);
    if (IN(4)) {
        { pg8::Gemm g{Qb, (const bf16*)(ws + WS_WG), TT, D, D, D, D, 0}; pg8::StaticOrder S; S.init(TT, D, F.G, (int)blockIdx.x);
          EpiGate2 E{SG, ss1};
          pg8::gemm_phase<EpiGate2, pg8::StaticOrder, true>(F.lds + RING_OFF, g, S, E); }
        { pg8::Gemm g{Qb, (const bf16*)(ws + WS_WDFT), TT, 2048, 256, D, 256, 2}; pg8::StaticOrder S; S.init(TT, 2048, F.G, (int)blockIdx.x);
          EpiChanDft E{ZY, ss1};
          pg8::gemm_phase<EpiChanDft, pg8::StaticOrder, true>(F.lds + RING_OFF, g, S, E); }
    } SEAM(4);
    if (IN(5)) { stage1_naive(F); } SEAM(5);
    if (IN(6)) { stage2_naive(F); } SEAM(6);
    if (IN(7)) {
        pg8::Gemm g{Qb, (const bf16*)(ws + WS_WO2), TT, D, D, D, D, 0}; pg8::StaticOrder S; S.init(TT, D, F.G, (int)blockIdx.x);
        EpiResid E{F.xp, F.xs, 1, F.out, nullptr, ss2};
        pg8::gemm_phase<EpiResid, pg8::StaticOrder, true>(F.lds + RING_OFF, g, S, E);
    } SEAM(7);
    if (IN(8)) { final_norm(F); }
#undef IN
#undef SEAM
}

extern "C" void kernel_launch(void* const* d_in, const int* in_sizes, int n_in, void* d_out, int out_size, void* d_ws, size_t ws_size, hipStream_t stream) {
    static int grid = 0;
    if (grid == 0) {
        if (n_in != 11 || in_sizes[0] != T_PROMPT * D || in_sizes[1] != T_SAMPLE * D || out_size != TT * D || ws_size < WS_END) {
            fprintf(stderr, "kernel_launch: unexpected shapes (n_in %d, in0 %d, in1 %d, out %d, ws %zu); nothing launched\n", n_in, n_in > 0 ? in_sizes[0] : -1, n_in > 1 ? in_sizes[1] : -1, out_size, ws_size); grid = -1; return; }
        int dev = 0, cus = 0, per_cu = 0;
        if (hipGetDevice(&dev) != hipSuccess || hipDeviceGetAttribute(&cus, hipDeviceAttributeMultiprocessorCount, dev) != hipSuccess) { grid = -1; return; }
        if (hipFuncSetAttribute((const void*)mk_fwd, hipFuncAttributeMaxDynamicSharedMemorySize, LDS_BYTES) != hipSuccess) { fprintf(stderr, "kernel_launch: hipFuncSetAttribute failed\n"); grid = -1; return; }
        if (hipOccupancyMaxActiveBlocksPerMultiprocessor(&per_cu, (const void*)mk_fwd, NTHR, LDS_BYTES) != hipSuccess || per_cu < 1) { fprintf(stderr, "kernel_launch: occupancy query says %d blocks per CU\n", per_cu); grid = -1; (void)hipGetLastError(); return; }
        (void)hipGetLastError();
        grid = cus;
    }
    if (grid < 0) return;
    (void)hipMemsetAsync((char*)d_ws + WS_CTL, 0, CTL_ZERO_BYTES, stream);
    Args a{};
    for (int i = 0; i < 11; ++i) a.in[i] = (const float*)d_in[i];
    a.out = (float*)d_out; a.ws = (unsigned char*)d_ws;
#if MK_ONE_LAUNCH
    a.ph_lo = 0; a.ph_hi = NPH;
    hipLaunchKernelGGL(mk_fwd, dim3(grid), dim3(NTHR), LDS_BYTES, stream, a);
#else
    for (int p = 0; p < NPH; ++p) { a.ph_lo = p; a.ph_hi = p + 1; hipLaunchKernelGGL(mk_fwd, dim3(grid), dim3(NTHR), LDS_BYTES, stream, a); }
#endif
}
```

```cpp
#include <hip/hip_runtime.h>
#include <cstdio>
#include <cstdint>

namespace pg8 {
#define PG8_LAS __attribute__((address_space(3)))
typedef unsigned short bf16_t;
typedef short bf16x8 __attribute__((ext_vector_type(8)));
typedef float f32x4 __attribute__((ext_vector_type(4)));
typedef unsigned u32x4 __attribute__((ext_vector_type(4)));
constexpr int BM = 256, BK = 64, HALF = 128, HTB = HALF * BK * 2  , STAGE_BYTES = 8 * HTB, NXCD = 8, WGM = 8;

__host__ __device__ __forceinline__ int lds_byte(int r, int c) { const int st = (r >> 4) * 2 + (c >> 5), rr = r & 15, cc = c & 31, ob = rr * 64 + cc * 2; return st * 1024 + (ob ^ (((ob >> 9) & 1) << 5)); }
__host__ __device__ __forceinline__ void stage_rc(int b, int& R, int& C) { const int st = b / 1024, sb = b % 1024, swz = sb ^ (((sb >> 9) & 1) << 5); R = (st >> 1) * 16 + swz / 64; C = (st & 1) * 32 + (swz % 64) / 2; }
__host__ __device__ __forceinline__ int perm32(int rho) { const int n = rho >> 4, i = rho & 15; return 8 * (i >> 2) + 4 * n + (i & 3); }

struct Unit { int pm, pn; };
struct Gemm { const bf16_t* A; const bf16_t* Bt; int M, N, K, lda, ldb, a_grp; };

struct StaticOrder {
    int nM, nN, nwg, G, c;
    __host__ __device__ void init(int M, int N, int G_, int c_) { nM = M / BM; nN = N / BM; nwg = nM * nN; G = G_; c = c_; }
    __host__ __device__ bool next(int i, Unit& u) const {
        const long L = (long)i * G + c; if (L >= nwg) return false;
        int wgid = (int)L; { const int q = nwg / NXCD, r = nwg % NXCD, xcd = wgid % NXCD, off = wgid / NXCD; wgid = (xcd < r ? xcd * (q + 1) : r * (q + 1) + (xcd - r) * q) + off; }
        const int nig = WGM * nN, gid = wgid / nig, fm = gid * WGM, gsz = (nM - fm) < WGM ? (nM - fm) : WGM;
        u.pm = fm + ((wgid % nig) % gsz); u.pn = (wgid % nig) / gsz; return true;
    }
};

__device__ __forceinline__ unsigned cvt_pk_bf16(float lo, float hi) { unsigned r; asm volatile("v_cvt_pk_bf16_f32 %0, %1, %2" : "=v"(r) : "v"(lo), "v"(hi)); return r; }

template <class Epi, class Sched, bool ALIGN_EPI = false>
__device__ __forceinline__ void gemm_phase(PG8_LAS unsigned char* lds, const Gemm g, const Sched& S, const Epi& E) {
    const int tid = threadIdx.x, wid = __builtin_amdgcn_readfirstlane(tid >> 6), lane = tid & 63, wr = wid >> 2, wc = wid & 3, fr = lane & 15, fq = lane >> 4;
    const int K = g.K, nt = K / BK;
    unsigned voffA[2], voffB[2];
#pragma unroll
    for (int i = 0; i < 2; ++i) { int R, C; stage_rc(tid * 16 + i * 8192, R, C); const int Rb = Epi::PERM ? ((R & ~31) + perm32(R & 31)) : R;
        voffA[i] = (unsigned)(R * g.lda + C) * 2u; voffB[i] = (unsigned)(Rb * g.ldb + C) * 2u; }
    const size_t kstep = (size_t)(BK * 2);
    const size_t hstepA = (size_t)HALF * g.lda * 2, hstepB = (size_t)HALF * g.ldb * 2;
    const size_t tstepA = 2 * hstepA, tstepB = 2 * hstepB;
    const unsigned ldsw = (unsigned)wid * 1024u;
    const int aoff = lds_byte(wr * 64 + fr, fq * 8), boff = lds_byte(wc * 32 + fr, fq * 8);
#define PG8_SA(b, h) (((b) * 2 + (h)) * HTB)
#define PG8_SB(b, h) ((4 + (b) * 2 + (h)) * HTB)
#define PG8_STAGE(bufoff, gbase, voff) do { _Pragma("unroll") for (int _i = 0; _i < 2; ++_i) \
        __builtin_amdgcn_global_load_lds((const unsigned*)((const char*)(gbase) + (voff)[_i]), (PG8_LAS unsigned*)(lds + (bufoff) + ldsw + _i * 8192), 16, 0, 0); } while (0)
#define PG8_LDA(dst, b, h) do { _Pragma("unroll") for (int m = 0; m < 4; ++m) _Pragma("unroll") for (int k = 0; k < 2; ++k) dst[m][k] = *(const PG8_LAS bf16x8*)(lds + PG8_SA(b, h) + aoff + m * 2048 + k * 1024); } while (0)
#define PG8_LDB(dst, b, h) do { _Pragma("unroll") for (int n = 0; n < 2; ++n) _Pragma("unroll") for (int k = 0; k < 2; ++k) dst[n][k] = *(const PG8_LAS bf16x8*)(lds + PG8_SB(b, h) + boff + n * 2048 + k * 1024); } while (0)
#define PG8_MMA(ai, bj, At, Bt) do { __builtin_amdgcn_s_setprio(1); _Pragma("unroll") for (int m = 0; m < 4; ++m) _Pragma("unroll") for (int n = 0; n < 2; ++n) _Pragma("unroll") for (int k = 0; k < 2; ++k) \
        acc[ai][bj][m][n] = __builtin_amdgcn_mfma_f32_16x16x32_bf16(Bt[n][k], At[m][k], acc[ai][bj][m][n], 0, 0, 0); __builtin_amdgcn_s_setprio(0); } while (0)
#define PG8_WAIT_V(n) asm volatile("s_waitcnt vmcnt(" #n ")" ::: "memory")
#define PG8_WAIT_L(n) asm volatile("s_waitcnt lgkmcnt(" #n ")" ::: "memory")
#define PG8_BAR __builtin_amdgcn_s_barrier()
#define PG8_SCHED __builtin_amdgcn_sched_barrier(0)
#define PG8_ABASE(u) ((const char*)g.A + (size_t)(u).pm * tstepA + (g.a_grp ? (size_t)((u).pn / g.a_grp) * (size_t)K * 2 : (size_t)0))
#define PG8_BBASE(u) ((const char*)g.Bt + (size_t)(u).pn * tstepB)
    Unit cur, nxt; int ui = 0;
    if (!S.next(0, cur)) return;
    f32x4 acc[2][2][4][2];
#pragma unroll
    for (int a = 0; a < 2; ++a)
#pragma unroll
        for (int b = 0; b < 2; ++b)
#pragma unroll
            for (int m = 0; m < 4; ++m)
#pragma unroll
                for (int n = 0; n < 2; ++n) acc[a][b][m][n] = (f32x4){0.f, 0.f, 0.f, 0.f};
    bf16x8 At[4][2], B0[2][2], B1[2][2];
    const char* cA = PG8_ABASE(cur); const char* cB = PG8_BBASE(cur);
    PG8_STAGE(PG8_SB(0, 0), cB, voffB); PG8_STAGE(PG8_SB(0, 1), cB + hstepB, voffB); PG8_STAGE(PG8_SA(0, 0), cA, voffA); PG8_STAGE(PG8_SA(0, 1), cA + hstepA, voffA);
    if (wr == 1) PG8_BAR;
    PG8_WAIT_V(2); PG8_BAR;
    PG8_STAGE(PG8_SB(1, 0), cB + kstep, voffB); PG8_STAGE(PG8_SA(1, 0), cA + kstep, voffA); PG8_STAGE(PG8_SB(1, 1), cB + hstepB + kstep, voffB);
    PG8_WAIT_V(6); PG8_BAR;
    for (;;) {
        const bool has_next = S.next(ui + 1, nxt);
        const char* nA = has_next ? PG8_ABASE(nxt) : cA; const char* nB = has_next ? PG8_BBASE(nxt) : cB;
        for (int t = 0; t < nt; t += 2) {
            const bool last = (t == nt - 2);
            const char* a1 = cA + (size_t)(t + 1) * kstep;
            const char* a2 = last ? nA : cA + (size_t)(t + 2) * kstep; const char* b2 = last ? nB : cB + (size_t)(t + 2) * kstep;
            const char* a3 = a2 + kstep; const char* b3 = b2 + kstep;
            PG8_LDB(B0, 0, 0); PG8_LDB(B1, 0, 1); PG8_SCHED; PG8_LDA(At, 0, 0); PG8_STAGE(PG8_SA(1, 1), a1 + hstepA, voffA);
            PG8_WAIT_V(8); PG8_WAIT_L(0); PG8_BAR; PG8_MMA(0, 0, At, B0); PG8_MMA(0, 1, At, B1); PG8_BAR; PG8_SCHED;
            PG8_LDA(At, 0, 1); PG8_STAGE(PG8_SB(0, 0), b2, voffB); PG8_STAGE(PG8_SB(0, 1), b2 + hstepB, voffB); PG8_STAGE(PG8_SA(0, 0), a2, voffA);
            PG8_WAIT_V(8); PG8_WAIT_L(0); PG8_BAR; PG8_MMA(1, 0, At, B0); PG8_MMA(1, 1, At, B1); PG8_BAR; PG8_SCHED;
            PG8_LDB(B0, 1, 0); PG8_LDB(B1, 1, 1); PG8_SCHED; PG8_LDA(At, 1, 0); PG8_STAGE(PG8_SA(0, 1), a2 + hstepA, voffA);
            PG8_WAIT_V(8); PG8_WAIT_L(0); PG8_BAR; PG8_MMA(0, 0, At, B0); PG8_MMA(0, 1, At, B1); PG8_BAR; PG8_SCHED;
            PG8_LDA(At, 1, 1); PG8_STAGE(PG8_SB(1, 0), b3, voffB); PG8_STAGE(PG8_SB(1, 1), b3 + hstepB, voffB); PG8_STAGE(PG8_SA(1, 0), a3, voffA);
            PG8_WAIT_V(8); PG8_WAIT_L(0); PG8_BAR; PG8_MMA(1, 0, At, B0); PG8_MMA(1, 1, At, B1); PG8_BAR; PG8_SCHED;
        }
        if constexpr (ALIGN_EPI) { if (wr == 0) PG8_BAR; }
        E(acc, cur, wr, wc, fr, fq);
        if (!has_next) break;
#pragma unroll
        for (int a = 0; a < 2; ++a)
#pragma unroll
            for (int b = 0; b < 2; ++b)
#pragma unroll
                for (int m = 0; m < 4; ++m)
#pragma unroll
                    for (int n = 0; n < 2; ++n) acc[a][b][m][n] = (f32x4){0.f, 0.f, 0.f, 0.f};
        cur = nxt; cA = nA; cB = nB; ++ui;
        if constexpr (ALIGN_EPI) { if (wr == 1) PG8_BAR; }
    }
    PG8_WAIT_V(0);
    if constexpr (!ALIGN_EPI) { if (wr == 0) PG8_BAR; }
    PG8_BAR;
#undef PG8_SA
#undef PG8_SB
#undef PG8_STAGE
#undef PG8_LDA
#undef PG8_LDB
#undef PG8_MMA
#undef PG8_WAIT_V
#undef PG8_WAIT_L
#undef PG8_BAR
#undef PG8_SCHED
#undef PG8_ABASE
#undef PG8_BBASE
}
}

constexpr int NWAVES = 8, NTHR = 512;
#ifndef USE_MFMA_ATTN
#define USE_MFMA_ATTN 1
#endif
#ifndef USE_MFMA_DFT
#define USE_MFMA_DFT 1
#endif
#ifndef MK_ONE_LAUNCH
#define MK_ONE_LAUNCH 1
#endif
constexpr int D = 1024;
constexpr int T_PROMPT = 2 * 16384, T_SAMPLE = 4 * 4096, TT = T_PROMPT + T_SAMPLE;
constexpr int NSEQ = 6;
constexpr int NH = 16, NKV = 4, HD = 64, KVW = 256, INW = 2560;
constexpr float RMS_EPS = 1e-6f;
constexpr float LOG2E = 1.4426950408889634f;
constexpr float QSCALE = 0.125f * LOG2E;
constexpr int N2 = 128;
constexpr int NPH = 9;

__host__ __device__ __forceinline__ int seq_base(int s) { return s < 2 ? s * 16384 : T_PROMPT + (s - 2) * 4096; }
__host__ __device__ __forceinline__ int seq_len(int s) { return s < 2 ? 16384 : 4096; }

constexpr size_t MiB = 1u << 20;
constexpr size_t WS_CTL = 0, CTL_ZERO_BYTES = 1 * MiB;
constexpr size_t WS_WIN = 1 * MiB;
constexpr size_t WS_WO = 6 * MiB;
constexpr size_t WS_WG = 8 * MiB;
constexpr size_t WS_WO2 = 10 * MiB;
constexpr size_t WS_WDFT = 12 * MiB;
constexpr size_t WS_TAB = 13 * MiB;
constexpr size_t TAB_A1P = 0;
constexpr size_t TAB_A1S = 128 * 1024;
constexpr size_t TAB_A2 = 144 * 1024;
constexpr size_t TAB_BIAS = 208 * 1024;
constexpr size_t TAB_INV0 = 256 * 1024;
constexpr size_t WS_SS1 = 14 * MiB;
constexpr size_t WS_SS2 = 17 * MiB;
constexpr size_t WS_ZY = 20 * MiB;
constexpr size_t WS_XB = 20 * MiB;
constexpr size_t WS_K = 116 * MiB;
constexpr size_t WS_V = 140 * MiB;
constexpr size_t WS_Q = 212 * MiB;
constexpr size_t WS_SG = 308 * MiB;
constexpr size_t WS_END = 404 * MiB;
constexpr int CW_BAR = 4096;

constexpr int RING_OFF = 0, RING_BYTES = 162816;
constexpr int LDSCTL_OFF = RING_BYTES, MISC_OFF = LDSCTL_OFF + 320;
constexpr int LDS_BYTES = 163840;

#define GAS __attribute__((address_space(1)))
#define LAS __attribute__((address_space(3)))
typedef unsigned short bf16;
typedef unsigned v4u __attribute__((ext_vector_type(4)));
typedef unsigned v2u __attribute__((ext_vector_type(2)));
typedef float f32x4 __attribute__((ext_vector_type(4)));
typedef GAS unsigned gu32;
#define RLX_AGENT __ATOMIC_RELAXED, __HIP_MEMORY_SCOPE_AGENT
#define LDS_WAIT() asm volatile("s_waitcnt lgkmcnt(0)" ::: "memory")
#define VM_WAIT() asm volatile("s_waitcnt vmcnt(0)" ::: "memory")
__device__ __forceinline__ unsigned f2bf(float f) { unsigned u = __builtin_bit_cast(unsigned, f); return (u + 0x7fffu + ((u >> 16) & 1u)) >> 16; }
__device__ __forceinline__ unsigned pk2(float lo, float hi) { return f2bf(lo) | (f2bf(hi) << 16); }
__device__ __forceinline__ float bf2f(unsigned short b) { return __builtin_bit_cast(float, (unsigned)b << 16); }
__device__ __forceinline__ float bflo(unsigned w) { return __builtin_bit_cast(float, w << 16); }
__device__ __forceinline__ float bfhi(unsigned w) { return __builtin_bit_cast(float, w & 0xffff0000u); }
__device__ __forceinline__ float silu_f(float x) { return x * __builtin_amdgcn_rcpf(1.0f + __builtin_amdgcn_exp2f(-x * LOG2E)); }

#define XB_TMO      128
#define XB_XCNT(j)  (256  + 64 * (j))
#define XB_XSUB(j)  (1280 + 64 * (j))
#define XB_XGEN(j)  (2304 + 64 * (j))
#define XB_TOP      3328
#define XB_TOPGEN   3392
#define XCD_BAR_WORDS 3456
#define XB_SPIN_CAP (1u << 18)
__device__ __forceinline__ unsigned xb_ld(unsigned* p)              { return __hip_atomic_load(p, __ATOMIC_RELAXED, __HIP_MEMORY_SCOPE_AGENT); }
__device__ __forceinline__ unsigned xb_add(unsigned* p, unsigned v) { return __hip_atomic_fetch_add(p, v, __ATOMIC_RELAXED, __HIP_MEMORY_SCOPE_AGENT); }
__device__ __forceinline__ unsigned xb_xcc_id() { return (unsigned)__builtin_amdgcn_s_getreg((3 << 11) | 20) & 0xFu; }
#define XB_SPIN(cond, bar) do { unsigned _sp = 0; while (cond) { __builtin_amdgcn_s_sleep(1); \
    if ((++_sp & 255u) == 0u) { if (xb_ld(&(bar)[XB_TMO])) break; if (_sp > XB_SPIN_CAP) { atomicAdd(&(bar)[XB_TMO], 1u); break; } } } } while (0)
struct XcdBarrier { unsigned* bar; unsigned x; volatile LAS unsigned* st; };
__device__ __forceinline__ XcdBarrier xcd_barrier_post(unsigned* bar, volatile LAS unsigned* st) {
    XcdBarrier b; b.bar = bar; b.x = xb_xcc_id(); b.st = st;
    if (threadIdx.x == 0) (void)xb_add(&bar[XB_XCNT(b.x)], 1u);
    return b;
}
__device__ __forceinline__ void xcd_barrier_complete(unsigned* bar, unsigned x, unsigned& nloc, unsigned& nx) {
    const unsigned G = gridDim.x * gridDim.y * gridDim.z;
    unsigned sum, cnt, mine, sp = 0u;
    for (;;) {
        sum = 0u; cnt = 0u; mine = 0u;
#pragma unroll
        for (unsigned j = 0; j < 16; ++j) { const unsigned c = xb_ld(&bar[XB_XCNT(j)]); sum += c; cnt += (c > 0u) ? 1u : 0u; mine = (j == x) ? c : mine; }
        if (sum == G) break;
        __builtin_amdgcn_s_sleep(1);
        if ((++sp & 255u) == 0u) { if (xb_ld(&bar[XB_TMO])) break; if (sp > XB_SPIN_CAP) { atomicAdd(&bar[XB_TMO], 1u); break; } }
    }
    nloc = mine > 0u ? mine : 1u; nx = cnt > 0u ? cnt : 1u;
}
__device__ __forceinline__ void xcd_barrier(const XcdBarrier& b) {
    asm volatile("s_waitcnt vmcnt(0)" ::: "memory");
    __syncthreads();
    if (threadIdx.x == 0) {
        unsigned* bar = b.bar;
        __builtin_amdgcn_s_waitcnt(0);
        unsigned nloc = b.st[0], nx = b.st[1];
        if (nloc == 0u) { xcd_barrier_complete(bar, b.x, nloc, nx); b.st[0] = nloc; b.st[1] = nx; }
        const unsigned old = xb_add(&bar[XB_XSUB(b.x)], 1u);
        const unsigned gen = old / nloc;
        if (old + 1u == (gen + 1u) * nloc) {
            __builtin_amdgcn_fence(__ATOMIC_RELEASE, "agent");
            asm volatile("s_waitcnt vmcnt(0)" ::: "memory");
            const unsigned og = xb_add(&bar[XB_TOP], 1u);
            const unsigned tg = og / nx;
            if (og + 1u == (tg + 1u) * nx) xb_add(&bar[XB_TOPGEN], 1u);
            else XB_SPIN(xb_ld(&bar[XB_TOPGEN]) == tg, bar);
            __builtin_amdgcn_fence(__ATOMIC_ACQUIRE, "agent");
            xb_add(&bar[XB_XGEN(b.x)], 1u);
            asm volatile("s_waitcnt vmcnt(0)" ::: "memory");
        } else {
            XB_SPIN(xb_ld(&bar[XB_XGEN(b.x)]) == gen, bar);
            __builtin_amdgcn_fence(__ATOMIC_ACQUIRE, "agent");
            asm volatile("s_waitcnt vmcnt(0)" ::: "memory");
        }
    }
    __syncthreads();
}

struct Frame {
    LAS unsigned char* lds;
    volatile LAS unsigned* MISC;
    gu32* ctl;
    int tid, lane, wave, vcu, G;
    const float *xp, *xs, *relb, *g1, *win, *wo, *sink, *g2, *wg, *wo2, *gf;
    float* out;
    unsigned char* ws;
};
__device__ __forceinline__ const float* xin_row(const Frame& F, int row) { return row < T_PROMPT ? F.xp + (size_t)row * D : F.xs + (size_t)(row - T_PROMPT) * D; }
__device__ __forceinline__ float wave_sum(float v) {
#pragma unroll
    for (int o = 1; o < 64; o <<= 1) v += __shfl_xor(v, o);
    return v;
}

__device__ __forceinline__ void p0_transpose_item(const float* W, const float* gain, int K, int N, bf16* WT, LAS float* scr, int item, int lane) {
    const int nblk = N / 32, kb = item / nblk, nb = item % nblk, k0 = 64 * kb, n0 = 32 * nb;
#pragma unroll 8
    for (int i = 0; i < 32; ++i) { const int kk = 2 * i + (lane >> 5); const float gv = gain ? gain[k0 + kk] : 1.0f; scr[kk * 33 + (lane & 31)] = gv * W[(size_t)(k0 + kk) * N + n0 + (lane & 31)]; }
    LDS_WAIT(); asm volatile("" ::: "memory");
    const int c = lane & 7;
#pragma unroll
    for (int j = 0; j < 4; ++j) { const int n = (lane >> 3) + 8 * j; const LAS float* s = scr + (8 * c) * 33 + n;
        v4u o; o.x = pk2(s[0 * 33], s[1 * 33]); o.y = pk2(s[2 * 33], s[3 * 33]); o.z = pk2(s[4 * 33], s[5 * 33]); o.w = pk2(s[6 * 33], s[7 * 33]);
        *(GAS v4u*)(WT + (size_t)(n0 + n) * K + k0 + 8 * c) = o; }
    LDS_WAIT(); asm volatile("" ::: "memory");
}
__host__ __device__ __forceinline__ void m_to_k1part(int m, int& k1, int& part) { const int w = m >> 5, j = m & 31; part = (j >> 3) & 1; k1 = 16 * w + (j & 7) + 8 * (j >> 4); }
__host__ __device__ __forceinline__ int t5_bucket(int rel) {
    const int n = -rel; const int a = n < 0 ? -n : n;
    const int b = a < 8 ? a : (a < 12 ? 8 : a < 16 ? 9 : a < 23 ? 10 : a < 32 ? 11 : a < 46 ? 12 : a < 64 ? 13 : a < 91 ? 14 : 15);
    return (n < 0 ? 16 : 0) + b;
}
__device__ __forceinline__ void p0_prologue(Frame& F) {
    LAS float* scr = (LAS float*)(F.lds + RING_OFF + F.wave * 16384);
    const int gw = F.vcu * NWAVES + F.wave, NGW = F.G * NWAVES;
    constexpr int I_IN = (D / 64) * (INW / 32), I_SQ = (D / 64) * (D / 32);
    constexpr int NITEMS = I_IN + 3 * I_SQ;
    bf16* win_t = (bf16*)(F.ws + WS_WIN); bf16* wo_t = (bf16*)(F.ws + WS_WO); bf16* wg_t = (bf16*)(F.ws + WS_WG); bf16* wo2_t = (bf16*)(F.ws + WS_WO2);
    for (int it = gw; it < NITEMS; it += NGW) {
        int r = it;
        if (r < I_IN) { p0_transpose_item(F.win, F.g1, D, INW, win_t, scr, r, F.lane); continue; } r -= I_IN;
        if (r < I_SQ) { p0_transpose_item(F.wo, nullptr, D, D, wo_t, scr, r, F.lane); continue; } r -= I_SQ;
        if (r < I_SQ) { p0_transpose_item(F.wg, F.g2, D, D, wg_t, scr, r, F.lane); continue; } r -= I_SQ;
        p0_transpose_item(F.wo2, nullptr, D, D, wo2_t, scr, r, F.lane);
    }
    const int gt = (F.vcu * NTHR) + F.tid, NGT = F.G * NTHR;
    bf16* wdft = (bf16*)(F.ws + WS_WDFT);
    for (int e = gt; e < 2048 * 256; e += NGT) {
        const int np = e >> 8, c = e & 255, g = np >> 9, ri = (np >> 8) & 1, cp = np & 255;
        const int t = (c * cp) & 255; float sn, cs; sincospif((float)t * (1.0f / 128.0f), &sn, &cs);
        const float v = F.g2[g * 256 + c] * (ri ? -sn : cs) * (1.0f / 16.0f);
        wdft[e] = (bf16)f2bf(v);
    }
    bf16* a1p = (bf16*)(F.ws + WS_TAB + TAB_A1P);
    for (int e = gt; e < 256 * 256; e += NGT) {
        const int m = e >> 8, k = e & 255, ri = k >> 7, s1 = k & 127; int k1, part; m_to_k1part(m, k1, part);
        const int t = (s1 * k1) & 127; float sn, cs; sincospif((float)t * (1.0f / 64.0f), &sn, &cs);
        const float v = (part == 0 ? (ri == 0 ? cs : sn) : (ri == 0 ? -sn : cs)) * 0.08838834764831845f;
        a1p[e] = (bf16)f2bf(v);
    }
    bf16* a1s = (bf16*)(F.ws + WS_TAB + TAB_A1S);
    for (int e = gt; e < 64 * 64; e += NGT) {
        const int m = e >> 6, k = e & 63, ri = k >> 5, s1 = k & 31; int k1, part; m_to_k1part(m, k1, part);
        const int t = (s1 * k1) & 31; float sn, cs; sincospif((float)t * (1.0f / 16.0f), &sn, &cs);
        const float v = (part == 0 ? (ri == 0 ? cs : sn) : (ri == 0 ? -sn : cs)) * 0.17677669529663687f;
        a1s[e] = (bf16)f2bf(v);
    }
    bf16* a2 = (bf16*)(F.ws + WS_TAB + TAB_A2);
    for (int e = gt; e < 128 * 256; e += NGT) {
        const int k2 = e >> 8, k = e & 255, ri = k >> 7, s2 = k & 127;
        const int t = (s2 * k2) & 127; float sn, cs; sincospif((float)t * (1.0f / 64.0f), &sn, &cs);
        a2[e] = (bf16)f2bf((ri == 0 ? cs : sn) * 0.08838834764831845f);
    }
    float* biasT = (float*)(F.ws + WS_TAB + TAB_BIAS);
    for (int e = gt; e < 16 * 272 + 16; e += NGT) {
        if (e < 16 * 272) { const int h = e / 272, r = e % 272; const int rel = (r > 256 ? 256 : r) - 128; biasT[e] = F.relb[t5_bucket(rel) * NH + h] * LOG2E; }
        else biasT[e] = F.sink[e - 16 * 272] * LOG2E;
    }
    bf16* xb = (bf16*)(F.ws + WS_XB); float* inv0 = (float*)(F.ws + WS_TAB + TAB_INV0);
    for (int m = gw; m < TT; m += NGW) {
        const GAS f32x4* xr = (const GAS f32x4*)xin_row(F, m) + F.lane;
        f32x4 v[4]; float s = 0.f;
#pragma unroll
        for (int j = 0; j < 4; ++j) { v[j] = xr[64 * j]; s += (v[j].x * v[j].x + v[j].y * v[j].y) + (v[j].z * v[j].z + v[j].w * v[j].w); }
        s = wave_sum(s);
        if (F.lane == 0) inv0[m] = 1.0f / sqrtf(s * (1.0f / D) + RMS_EPS);
        GAS v2u* o8 = (GAS v2u*)(xb + (size_t)m * D) + F.lane;
#pragma unroll
        for (int j = 0; j < 4; ++j) { v2u w; w.x = pk2(v[j].x, v[j].y); w.y = pk2(v[j].z, v[j].w); o8[64 * j] = w; }
    }
}

using pg8::cvt_pk_bf16;
typedef pg8::f32x4 accv;
#define EPI_ROW(u, ai, m) ((u).pm * 256 + (ai) * 128 + wr * 64 + (m) * 16 + fr)
#define EPI_COL(bj) ((bj) * 128 + wc * 32 + 8 * fq)
__device__ __forceinline__ v4u pack8(accv a, accv b) { v4u w; w.x = cvt_pk_bf16(a[0], a[1]); w.y = cvt_pk_bf16(a[2], a[3]); w.z = cvt_pk_bf16(b[0], b[1]); w.w = cvt_pk_bf16(b[2], b[3]); return w; }
__device__ __forceinline__ accv silu4(accv v) { accv o; o[0] = silu_f(v[0]); o[1] = silu_f(v[1]); o[2] = silu_f(v[2]); o[3] = silu_f(v[3]); return o; }

struct EpiInProj {
    static constexpr bool PERM = true;
    bf16 *Q, *Kb, *Vb, *SG; const float* inv0;
    __device__ __forceinline__ void operator()(const accv (&acc)[2][2][4][2], const pg8::Unit& u, int wr, int wc, int fr, int fq) const {
        const int pn = u.pn;
#pragma unroll
        for (int ai = 0; ai < 2; ++ai)
#pragma unroll
            for (int m = 0; m < 4; ++m) {
                const int row = EPI_ROW(u, ai, m); const float inv = inv0[row];
#pragma unroll
                for (int bj = 0; bj < 2; ++bj) {
                    accv v0 = acc[ai][bj][m][0] * inv, v1 = acc[ai][bj][m][1] * inv; const int col = EPI_COL(bj);
                    if (pn < 4) { v0 = v0 * QSCALE; v1 = v1 * QSCALE; *(v4u*)(Q + (size_t)row * D + pn * 256 + col) = pack8(v0, v1); }
                    else if (pn == 4) { *(v4u*)(Kb + (size_t)row * KVW + col) = pack8(v0, v1); }
                    else if (pn == 5) { *(v4u*)(Vb + (size_t)row * KVW + col) = pack8(v0, v1); }
                    else { *(v4u*)(SG + (size_t)row * D + (pn - 6) * 256 + col) = pack8(silu4(v0), silu4(v1)); }
                }
            }
    }
};
struct EpiResid {
    static constexpr bool PERM = true;
    const float* xp; const float* xs; int in_place; float* out; bf16* xb; float* ss;
    __device__ __forceinline__ void operator()(const accv (&acc)[2][2][4][2], const pg8::Unit& u, int wr, int wc, int fr, int fq) const {
        const int pn = u.pn;
#pragma unroll
        for (int ai = 0; ai < 2; ++ai)
#pragma unroll
            for (int m = 0; m < 4; ++m) {
                const int row = EPI_ROW(u, ai, m);
                const float* src = in_place ? (const float*)out + (size_t)row * D : (row < T_PROMPT ? xp + (size_t)row * D : xs + (size_t)(row - T_PROMPT) * D);
                float q = 0.f;
#pragma unroll
                for (int bj = 0; bj < 2; ++bj) {
                    const int col = pn * 256 + EPI_COL(bj);
                    const accv r0 = *(const accv*)(src + col), r1 = *(const accv*)(src + col + 4);
                    const accv v0 = acc[ai][bj][m][0] + r0, v1 = acc[ai][bj][m][1] + r1;
                    q += (v0[0] * v0[0] + v0[1] * v0[1]) + (v0[2] * v0[2] + v0[3] * v0[3]) + (v1[0] * v1[0] + v1[1] * v1[1]) + (v1[2] * v1[2] + v1[3] * v1[3]);
                    *(accv*)(out + (size_t)row * D + col) = v0; *(accv*)(out + (size_t)row * D + col + 4) = v1;
                    if (xb) *(v4u*)(xb + (size_t)row * D + col) = pack8(v0, v1);
                }
                q += __shfl_xor(q, 16); q += __shfl_xor(q, 32);
                if (fq == 0) ss[(size_t)row * 16 + pn * 4 + wc] = q;
            }
    }
};
__device__ __forceinline__ float inv_from_ss(const float* ss, int row, int fq) {
    const accv p = *(const accv*)(ss + (size_t)row * 16 + fq * 4);
    float s = (p[0] + p[1]) + (p[2] + p[3]); s += __shfl_xor(s, 16); s += __shfl_xor(s, 32);
    return 1.0f / sqrtf(s * (1.0f / D) + RMS_EPS);
}
struct EpiGate2 {
    static constexpr bool PERM = true;
    bf16* SG; const float* ss;
    __device__ __forceinline__ void operator()(const accv (&acc)[2][2][4][2], const pg8::Unit& u, int wr, int wc, int fr, int fq) const {
#pragma unroll
        for (int ai = 0; ai < 2; ++ai)
#pragma unroll
            for (int m = 0; m < 4; ++m) {
                const int row = EPI_ROW(u, ai, m); const float inv = inv_from_ss(ss, row, fq);
#pragma unroll
                for (int bj = 0; bj < 2; ++bj) { const accv v0 = acc[ai][bj][m][0] * inv, v1 = acc[ai][bj][m][1] * inv;
                    *(v4u*)(SG + (size_t)row * D + u.pn * 256 + EPI_COL(bj)) = pack8(silu4(v0), silu4(v1)); }
            }
    }
};
struct EpiChanDft {
    static constexpr bool PERM = true;
    bf16* Z; const float* ss;
    __device__ __forceinline__ void operator()(const accv (&acc)[2][2][4][2], const pg8::Unit& u, int wr, int wc, int fr, int fq) const {
        const int g = u.pn >> 1, ri = u.pn & 1;
#pragma unroll
        for (int ai = 0; ai < 2; ++ai)
#pragma unroll
            for (int m = 0; m < 4; ++m) {
                const int row = EPI_ROW(u, ai, m); const float inv = inv_from_ss(ss, row, fq);
#pragma unroll
                for (int bj = 0; bj < 2; ++bj) { const accv v0 = acc[ai][bj][m][0] * inv, v1 = acc[ai][bj][m][1] * inv;
                    *(v4u*)(Z + (size_t)row * 2048 + ri * 1024 + g * 256 + EPI_COL(bj)) = pack8(v0, v1); }
            }
    }
};

constexpr int ATT_KROW = 66;
__device__ __forceinline__ void attn_naive(Frame& F) {
    const bf16* Q = (const bf16*)(F.ws + WS_Q); const bf16* Kb = (const bf16*)(F.ws + WS_K); const bf16* Vb = (const bf16*)(F.ws + WS_V);
    const bf16* SG = (const bf16*)(F.ws + WS_SG); bf16* OG = (bf16*)(F.ws + WS_XB);
    const float* biasT = (const float*)(F.ws + WS_TAB + TAB_BIAS);
    LAS unsigned short* Kl = (LAS unsigned short*)(F.lds); LAS unsigned short* Vl = Kl + 384 * ATT_KROW;
    const int nunits = (TT / 128) * NKV;
    for (int un = F.vcu; un < nunits; un += F.G) {
        const int blk = un >> 2, kvh = un & 3; const int row0 = blk * 128;
        int sq = 0; for (int s = 0; s < NSEQ; ++s) if (row0 >= seq_base(s)) sq = s;
        const int sb = seq_base(sq), sl = seq_len(sq), p0 = row0 - sb;
        __syncthreads();
        for (int e = F.tid; e < 384 * 8; e += NTHR) {
            const int j = e >> 3, c = e & 7; const int pos = p0 - 128 + j;
            v4u kv = (v4u){0u, 0u, 0u, 0u}, vv = kv;
            if (pos >= 0 && pos < sl) { kv = *(const v4u*)(Kb + (size_t)(sb + pos) * KVW + kvh * 64 + c * 8); vv = *(const v4u*)(Vb + (size_t)(sb + pos) * KVW + kvh * 64 + c * 8); }
            LAS unsigned* kd = (LAS unsigned*)(Kl + j * ATT_KROW + c * 8); kd[0] = kv.x; kd[1] = kv.y; kd[2] = kv.z; kd[3] = kv.w;
            LAS unsigned* vd = (LAS unsigned*)(Vl + j * ATT_KROW + c * 8); vd[0] = vv.x; vd[1] = vv.y; vd[2] = vv.z; vd[3] = vv.w;
        }
        __syncthreads();
        const int hl = F.tid >> 7, ql = F.tid & 127, h = kvh * 4 + hl, row = row0 + ql, pos = p0 + ql;
        float qv[64];
#pragma unroll
        for (int c = 0; c < 8; ++c) { const v4u w = *(const v4u*)(Q + (size_t)row * D + h * 64 + c * 8);
            qv[c * 8 + 0] = bflo(w.x); qv[c * 8 + 1] = bfhi(w.x); qv[c * 8 + 2] = bflo(w.y); qv[c * 8 + 3] = bfhi(w.y); qv[c * 8 + 4] = bflo(w.z); qv[c * 8 + 5] = bfhi(w.z); qv[c * 8 + 6] = bflo(w.w); qv[c * 8 + 7] = bfhi(w.w); }
        float mx = biasT[16 * 272 + h], l = 1.0f; float o[64];
#pragma unroll
        for (int d = 0; d < 64; ++d) o[d] = 0.f;
        for (int rel = -128; rel <= 128; ++rel) {
            const int kp = pos + rel; if (kp < 0 || kp >= sl) continue;
            const int j = ql + rel + 128;
            const LAS unsigned* kr = (const LAS unsigned*)(Kl + j * ATT_KROW);
            float s = 0.f;
#pragma unroll
            for (int c = 0; c < 32; ++c) { const unsigned w = kr[c]; s += qv[2 * c] * bflo(w) + qv[2 * c + 1] * bfhi(w); }
            s += biasT[h * 272 + rel + 128];
            const float mn = fmaxf(mx, s), sc = __builtin_amdgcn_exp2f(mx - mn), p = __builtin_amdgcn_exp2f(s - mn);
            l = l * sc + p; mx = mn;
            const LAS unsigned* vr = (const LAS unsigned*)(Vl + j * ATT_KROW);
#pragma unroll
            for (int c = 0; c < 32; ++c) { const unsigned w = vr[c]; o[2 * c] = o[2 * c] * sc + p * bflo(w); o[2 * c + 1] = o[2 * c + 1] * sc + p * bfhi(w); }
        }
        const float il = 1.0f / l;
#pragma unroll
        for (int c = 0; c < 8; ++c) { const v4u g = *(const v4u*)(SG + (size_t)row * D + h * 64 + c * 8); v4u w;
            w.x = pk2(o[c * 8 + 0] * il * bflo(g.x), o[c * 8 + 1] * il * bfhi(g.x)); w.y = pk2(o[c * 8 + 2] * il * bflo(g.y), o[c * 8 + 3] * il * bfhi(g.y));
            w.z = pk2(o[c * 8 + 4] * il * bflo(g.z), o[c * 8 + 5] * il * bfhi(g.z)); w.w = pk2(o[c * 8 + 6] * il * bflo(g.w), o[c * 8 + 7] * il * bfhi(g.w));
            *(v4u*)(OG + (size_t)row * D + h * 64 + c * 8) = w; }
    }
}

template <int NS, int MROWS>
__device__ __forceinline__ void dft_tile_naive(Frame& F, const bf16* A, const bf16* ZY, size_t rowbase, size_t rstride, int cb, float (&acc)[MROWS / 8]) {
    constexpr int KK = 2 * NS, MPT = MROWS / 8;
    LAS float* Bl = (LAS float*)(F.lds);
    __syncthreads();
    for (int e = F.tid; e < KK * 8; e += NTHR) {
        const int k = e >> 3, c = e & 7, ri = k / NS, s = k % NS;
        const v4u w = *(const v4u*)(ZY + (rowbase + (size_t)s * rstride) * 2048 + ri * 1024 + cb * 64 + c * 8);
        LAS float* d = Bl + k * 64 + c * 8;
        d[0] = bflo(w.x); d[1] = bfhi(w.x); d[2] = bflo(w.y); d[3] = bfhi(w.y); d[4] = bflo(w.z); d[5] = bfhi(w.z); d[6] = bflo(w.w); d[7] = bfhi(w.w);
    }
    __syncthreads();
    const int n = F.tid & 63, mg = __builtin_amdgcn_readfirstlane(F.tid >> 6);
#pragma unroll
    for (int i = 0; i < MPT; ++i) acc[i] = 0.f;
    for (int k = 0; k < KK; ++k) {
        const float b = Bl[k * 64 + n];
#pragma unroll
        for (int i = 0; i < MPT; ++i) acc[i] += bf2f(A[(mg * MPT + i) * KK + k]) * b;
    }
    __syncthreads();
}
__device__ __forceinline__ void stage1_naive(Frame& F) {
    bf16* ZY = (bf16*)(F.ws + WS_ZY);
    const bf16* a1p = (const bf16*)(F.ws + WS_TAB + TAB_A1P); const bf16* a1s = (const bf16*)(F.ws + WS_TAB + TAB_A1S);
    const int NU = 4096 + 8192;
    for (int un = F.vcu; un < NU; un += F.G) {
        const int n = F.tid & 63, mg = F.tid >> 6;
        if (un < 4096) {
            const int sq = un >> 11, s2 = (un >> 4) & 127, cb = un & 15; const size_t base = (size_t)seq_base(sq);
            float acc[32];
            dft_tile_naive<128, 256>(F, a1p, ZY, base + s2, 128, cb, acc);
#pragma unroll
            for (int i = 0; i < 32; ++i) if (((i >> 3) & 1) == 0) {
                const int k1 = 16 * mg + (i & 7) + 8 * (i >> 4); const float yr = acc[i], yi = acc[i + 8];
                const int t = (k1 * s2) & 16383; float sn, cs; sincospif((float)t * (1.0f / 8192.0f), &sn, &cs);
                const size_t orow = base + (size_t)k1 * 128 + s2;
                ZY[orow * 2048 + cb * 64 + n] = (bf16)f2bf(yr * cs + yi * sn);
                ZY[orow * 2048 + 1024 + cb * 64 + n] = (bf16)f2bf(yi * cs - yr * sn);
            }
        } else {
            const int v = un - 4096; const int sq = 2 + (v >> 11), s2 = (v >> 4) & 127, cb = v & 15; const size_t base = (size_t)seq_base(sq);
            float acc[8];
            dft_tile_naive<32, 64>(F, a1s, ZY, base + s2, 128, cb, acc);
            const int m0 = mg * 8; const int w = m0 >> 5, j0 = m0 & 31;
            const int part = (j0 >> 3) & 1;
            LAS float* X = (LAS float*)(F.lds);
#pragma unroll
            for (int i = 0; i < 8; ++i) X[(m0 + i) * 64 + n] = acc[i];
            __syncthreads();
            if (part == 0) {
#pragma unroll
                for (int i = 0; i < 8; ++i) {
                    const int k1 = 16 * w + i + 8 * (j0 >> 4); const float yr = acc[i], yi = X[(m0 + 8 + i) * 64 + n];
                    const int t = (k1 * s2) & 4095; float sn, cs; sincospif((float)t * (1.0f / 2048.0f), &sn, &cs);
                    const size_t orow = base + (size_t)k1 * 128 + s2;
                    ZY[orow * 2048 + cb * 64 + n] = (bf16)f2bf(yr * cs + yi * sn);
                    ZY[orow * 2048 + 1024 + cb * 64 + n] = (bf16)f2bf(yi * cs - yr * sn);
                }
            }
            __syncthreads();
        }
    }
}
__device__ __forceinline__ void stage2_naive(Frame& F) {
    const bf16* ZY = (const bf16*)(F.ws + WS_ZY); const bf16* a2 = (const bf16*)(F.ws + WS_TAB + TAB_A2);
    const bf16* SG = (const bf16*)(F.ws + WS_SG); bf16* U = (bf16*)(F.ws + WS_Q);
    const int NU = 4096 + 2048;
    for (int un = F.vcu; un < NU; un += F.G) {
        int sq, k1, cb, n1;
        if (un < 4096) { sq = un >> 11; k1 = (un >> 4) & 127; cb = un & 15; n1 = 128; }
        else { const int v = un - 4096; sq = 2 + (v >> 9); k1 = (v >> 4) & 31; cb = v & 15; n1 = 32; }
        const size_t base = (size_t)seq_base(sq);
        float acc[16];
        dft_tile_naive<128, 128>(F, a2, ZY, base + (size_t)k1 * 128, 1, cb, acc);
        const int n = F.tid & 63, mg = F.tid >> 6;
#pragma unroll
        for (int i = 0; i < 16; ++i) {
            const int k2 = mg * 16 + i; const size_t tok = base + k1 + (size_t)n1 * k2;
            const float g = bf2f(SG[tok * D + cb * 64 + n]);
            U[tok * D + cb * 64 + n] = (bf16)f2bf(acc[i] * g);
        }
    }
}

typedef short bf16x8 __attribute__((ext_vector_type(8)));
typedef short s16x4 __attribute__((ext_vector_type(4)));
typedef float f32x16 __attribute__((ext_vector_type(16)));
typedef __attribute__((address_space(3))) const char* lds_cptr;
__device__ __forceinline__ s16x4 vtr(lds_cptr p) { return __builtin_bit_cast(s16x4, __builtin_amdgcn_ds_read_tr16_b64_v4i16((__attribute__((address_space(3))) s16x4*)p)); }
__device__ __forceinline__ float swap_max(float m) { auto rr = __builtin_amdgcn_permlane32_swap(__float_as_uint(m), __float_as_uint(m), false, false); return fmaxf(__uint_as_float(rr[0]), __uint_as_float(rr[1])); }
__device__ __forceinline__ float swap_sum(float m) { auto rr = __builtin_amdgcn_permlane32_swap(__float_as_uint(m), __float_as_uint(m), false, false); return __uint_as_float(rr[0]) + __uint_as_float(rr[1]); }
__device__ __forceinline__ int crow(int r, int hi) { return (r & 3) + 8 * (r >> 2) + 4 * hi; }

template <int KK, int CB, int MB, int NBW>
struct DftCore {
    static constexpr int NKS = KK / 16, NCH = CB / 32, TILE_BYTES = KK * CB * 2, CPR = CB / 8, CHUNKS = KK * CPR, CPT = CHUNKS / NTHR, NS = KK / 2;
    static_assert(CHUNKS % NTHR == 0 && MB * 32 * 1 <= 256 && (8 / MB) * NBW * 32 == CB, "DftCore geometry");
    bf16x8 af[NKS];
    int mb, nq;
    __device__ __forceinline__ void init(const bf16* A, int wave, int lane) {
        mb = wave % MB; nq = wave / MB;
#pragma unroll
        for (int ks = 0; ks < NKS; ++ks) af[ks] = *(const bf16x8*)(A + (size_t)(32 * mb + (lane & 31)) * KK + ks * 16 + 8 * (lane >> 5));
    }
    __device__ __forceinline__ void issue(v4u (&regs)[CPT], const bf16* ZY, size_t rowbase, size_t rstride, int colbase, int tid) const {
#pragma unroll
        for (int i = 0; i < CPT; ++i) { const int e = tid + i * NTHR, k = e / CPR, c8 = e % CPR, ri = k / NS, s = k % NS;
            regs[i] = *(const v4u*)(ZY + (rowbase + (size_t)s * rstride) * 2048 + ri * 1024 + colbase + c8 * 8); }
    }
    __device__ __forceinline__ void write(const v4u (&regs)[CPT], LAS unsigned char* buf, int tid) const {
#pragma unroll
        for (int i = 0; i < CPT; ++i) { const int e = tid + i * NTHR, k = e / CPR, c8 = e % CPR;
            *(LAS v4u*)(buf + ((k >> 4) * NCH + (c8 >> 2)) * 1024 + (k & 15) * 64 + (c8 & 3) * 16) = regs[i]; }
    }
    __device__ __forceinline__ void compute(f32x16 (&acc)[NBW], LAS unsigned char* buf, int lane) const {
        const int hh = lane >> 5, g = (lane >> 4) & 1, i16 = lane & 15, q = i16 >> 2, p = i16 & 3;
        const lds_cptr base = (lds_cptr)buf + (8 * hh + q) * 64 + (16 * g + 4 * p) * 2;
#pragma unroll
        for (int nbi = 0; nbi < NBW; ++nbi) acc[nbi] = f32x16{};
#pragma unroll
        for (int ks = 0; ks < NKS; ++ks)
#pragma unroll
            for (int nbi = 0; nbi < NBW; ++nbi) {
                const lds_cptr a = base + (ks * NCH + nq * NBW + nbi) * 1024;
                const s16x4 t0 = vtr(a), t1 = vtr(a + 256);
                const bf16x8 b = (bf16x8){t0[0], t0[1], t0[2], t0[3], t1[0], t1[1], t1[2], t1[3]};
                acc[nbi] = __builtin_amdgcn_mfma_f32_32x32x16_bf16(af[ks], b, acc[nbi], 0, 0, 0);
            }
    }
};

constexpr int DFT_BUF0 = 0, DFT_BUF1 = 32768, DFT_STG = 65536;

template <bool PROMPT>
__device__ __forceinline__ void stage1_mfma(Frame& F) {
    constexpr int KK = PROMPT ? 256 : 64, CB = PROMPT ? 64 : 128, MB = PROMPT ? 8 : 2, NBW = PROMPT ? 2 : 1, NCB = 1024 / CB;
    constexpr int SLEN = PROMPT ? 16384 : 4096;
    typedef DftCore<KK, CB, MB, NBW> Core;
    bf16* ZY = (bf16*)(F.ws + WS_ZY);
    Core C; C.init((const bf16*)(F.ws + WS_TAB + (PROMPT ? TAB_A1P : TAB_A1S)), F.wave, F.lane);
    constexpr int NU = (PROMPT ? 2 : 4) * 128 * NCB;
    const int hh = F.lane >> 5, r32 = F.lane & 31;
    v4u regs[Core::CPT];
    int un = F.vcu; int it = 0;
#define S1_DECODE(u, sq, s2, cb) const int sq = (PROMPT ? 0 : 2) + (u) / (128 * NCB), s2 = ((u) / NCB) & 127, cb = (u) % NCB
    __syncthreads();
    if (un < NU) { S1_DECODE(un, sq, s2, cb); C.issue(regs, ZY, (size_t)seq_base(sq) + s2, 128, cb * CB, F.tid); C.write(regs, F.lds + DFT_BUF0, F.tid); }
    __syncthreads();
    for (; un < NU; un += F.G, ++it) {
        S1_DECODE(un, sq, s2, cb);
        const int nun = un + F.G;
        if (nun < NU) { S1_DECODE(nun, nsq, ns2, ncb); C.issue(regs, ZY, (size_t)seq_base(nsq) + ns2, 128, ncb * CB, F.tid); }
        LAS unsigned char* buf = F.lds + ((it & 1) ? DFT_BUF1 : DFT_BUF0);
        f32x16 acc[NBW];
        C.compute(acc, buf, F.lane);
        LAS unsigned short* stg = (LAS unsigned short*)(F.lds + DFT_STG);
#pragma unroll
        for (int t = 0; t < 8; ++t) {
            const int r = (t & 3) + 8 * (t >> 2);
            const int k1 = 16 * C.mb + (t & 3) + 4 * hh + 8 * (t >> 2);
            const float fr = (float)((k1 * s2) & (SLEN - 1)) * (1.0f / SLEN);
            const float cs = __builtin_amdgcn_cosf(fr), sn = __builtin_amdgcn_sinf(fr);
#pragma unroll
            for (int nbi = 0; nbi < NBW; ++nbi) {
                const float re = acc[nbi][r], im = acc[nbi][r + 4];
                const int col = (C.nq * NBW + nbi) * 32 + r32;
                stg[(2 * k1) * CB + col] = (unsigned short)f2bf(re * cs + im * sn);
                stg[(2 * k1 + 1) * CB + col] = (unsigned short)f2bf(im * cs - re * sn);
            }
        }
        LDS_WAIT(); __syncthreads();
        {
            constexpr int CPRW = CB / 8, NCHK = 32 * MB * CPRW / NTHR;
            const size_t base = (size_t)seq_base(sq);
#pragma unroll
            for (int i = 0; i < NCHK; ++i) { const int idx = F.tid + i * NTHR, rl = idx / CPRW, ch = idx % CPRW, k1 = rl >> 1, part = rl & 1;
                const v4u v = *(const LAS v4u*)((LAS unsigned char*)stg + (size_t)rl * CB * 2 + ch * 16);
                *(v4u*)(ZY + (base + (size_t)k1 * 128 + s2) * 2048 + part * 1024 + cb * CB + ch * 8) = v; }
        }
        if (nun < NU) C.write(regs, F.lds + ((it & 1) ? DFT_BUF0 : DFT_BUF1), F.tid);
        LDS_WAIT(); __syncthreads();
    }
#undef S1_DECODE
}

__device__ __forceinline__ void stage2_mfma(Frame& F) {
    typedef DftCore<256, 64, 4, 1> Core;
    const bf16* ZY = (const bf16*)(F.ws + WS_ZY); const bf16* SG = (const bf16*)(F.ws + WS_SG); bf16* U = (bf16*)(F.ws + WS_Q);
    Core C; C.init((const bf16*)(F.ws + WS_TAB + TAB_A2), F.wave, F.lane);
    constexpr int NU = 4096 + 2048;
    const int hh = F.lane >> 5, r32 = F.lane & 31;
    v4u regs[Core::CPT];
    int un = F.vcu; int it = 0;
#define S2_DECODE(u, sq, k1, cb, n1) int sq, k1, cb, n1; if ((u) < 4096) { sq = (u) >> 11; k1 = ((u) >> 4) & 127; cb = (u) & 15; n1 = 128; } else { const int v_ = (u) - 4096; sq = 2 + (v_ >> 9); k1 = (v_ >> 4) & 31; cb = v_ & 15; n1 = 32; }
    __syncthreads();
    if (un < NU) { S2_DECODE(un, sq, k1, cb, n1); (void)n1; C.issue(regs, ZY, (size_t)seq_base(sq) + (size_t)k1 * 128, 1, cb * 64, F.tid); C.write(regs, F.lds + DFT_BUF0, F.tid); }
    __syncthreads();
    for (; un < NU; un += F.G, ++it) {
        S2_DECODE(un, sq, k1, cb, n1);
        const int nun = un + F.G;
        if (nun < NU) { S2_DECODE(nun, nsq, nk1, ncb, nn1); (void)nn1; C.issue(regs, ZY, (size_t)seq_base(nsq) + (size_t)nk1 * 128, 1, ncb * 64, F.tid); }
        LAS unsigned char* buf = F.lds + ((it & 1) ? DFT_BUF1 : DFT_BUF0);
        f32x16 acc[1];
        C.compute(acc, buf, F.lane);
        LAS float* stg = (LAS float*)(F.lds + DFT_STG);
#pragma unroll
        for (int r = 0; r < 16; ++r) stg[(32 * C.mb + crow(r, hh)) * 64 + C.nq * 32 + r32] = acc[0][r];
        LDS_WAIT(); __syncthreads();
        {
            const size_t base = (size_t)seq_base(sq);
#pragma unroll
            for (int i = 0; i < 2; ++i) { const int idx = F.tid + i * NTHR, k2 = idx >> 3, ch = idx & 7;
                const size_t tok = base + k1 + (size_t)n1 * k2;
                const v4u g = *(const v4u*)(SG + tok * D + cb * 64 + ch * 8);
                const f32x4 f0 = *(const LAS f32x4*)(stg + k2 * 64 + ch * 8), f1 = *(const LAS f32x4*)(stg + k2 * 64 + ch * 8 + 4);
                v4u w; w.x = pk2(f0[0] * bflo(g.x), f0[1] * bfhi(g.x)); w.y = pk2(f0[2] * bflo(g.y), f0[3] * bfhi(g.y));
                w.z = pk2(f1[0] * bflo(g.z), f1[1] * bfhi(g.z)); w.w = pk2(f1[2] * bflo(g.w), f1[3] * bfhi(g.w));
                *(v4u*)(U + tok * D + cb * 64 + ch * 8) = w; }
        }
        if (nun < NU) C.write(regs, F.lds + ((it & 1) ? DFT_BUF0 : DFT_BUF1), F.tid);
        LDS_WAIT(); __syncthreads();
    }
#undef S2_DECODE
}

constexpr int AT_K = 0, AT_KSTRIDE = 385 * 16, AT_V = 49664, AT_BIAS = AT_V + 49152, AT_STG = AT_BIAS + 8192, AT_WSF = AT_STG + 32768, AT_END = AT_WSF + 8 * 256;
static_assert(8 * AT_KSTRIDE <= AT_V && AT_END <= RING_BYTES, "attention LDS map");
#ifndef ATT_THR
#define ATT_THR 8.0f
#endif
__device__ __forceinline__ void attn_mfma(Frame& F) {
    const bf16* Q = (const bf16*)(F.ws + WS_Q); const bf16* Kb = (const bf16*)(F.ws + WS_K); const bf16* Vb = (const bf16*)(F.ws + WS_V);
    const bf16* SG = (const bf16*)(F.ws + WS_SG); bf16* OG = (bf16*)(F.ws + WS_XB);
    const float* biasT = (const float*)(F.ws + WS_TAB + TAB_BIAS);
    LAS unsigned char* Kl = F.lds + AT_K; LAS unsigned char* Vl = F.lds + AT_V; LAS float* Bl = (LAS float*)(F.lds + AT_BIAS);
    LAS unsigned short* stg = (LAS unsigned short*)(F.lds + AT_STG + F.wave * 4096); LAS float* wsf = (LAS float*)(F.lds + AT_WSF + F.wave * 256);
    const int lane = F.lane, hh = lane >> 5, r32 = lane & 31, g = (lane >> 4) & 1, i16 = lane & 15, tq = i16 >> 2, tp = i16 & 3;
    const int nunits = (TT / 128) * NKV;
    for (int un = F.vcu; un < nunits; un += F.G) {
        const int blk = un >> 2, kvh = un & 3; const int row0 = blk * 128;
        int sq = 0; for (int s = 0; s < NSEQ; ++s) if (row0 >= seq_base(s)) sq = s;
        const int sb = seq_base(sq), sl = seq_len(sq), p0 = row0 - sb;
        const int jlo = p0 >= 128 ? 0 : 128 - p0, jhi = (sl - p0 + 128) < 384 ? (sl - p0 + 128) : 384;
        const bool edge = (jlo > 0) || (jhi < 384);
        __syncthreads();
#pragma unroll
        for (int i = 0; i < 6; ++i) {
            const int e = F.tid + i * NTHR, j = e >> 3, c = e & 7; const int pos = p0 - 128 + j;
            v4u kv = (v4u){0u, 0u, 0u, 0u}, vv = kv;
            if (pos >= 0 && pos < sl) { kv = *(const v4u*)(Kb + (size_t)(sb + pos) * KVW + kvh * 64 + c * 8); vv = *(const v4u*)(Vb + (size_t)(sb + pos) * KVW + kvh * 64 + c * 8); }
            *(LAS v4u*)(Kl + c * AT_KSTRIDE + j * 16) = kv;
            *(LAS v4u*)(Vl + ((j >> 4) * 2 + (c >> 2)) * 1024 + (j & 15) * 64 + (c & 3) * 16) = vv;
        }
#pragma unroll
        for (int i = 0; i < 4; ++i) { const int e = F.tid + i * NTHR, hl = e >> 9, idx = (e & 511) - 128;
            Bl[e] = (idx >= 0 && idx <= 256) ? biasT[(kvh * 4 + hl) * 272 + idx] : -INFINITY; }
        LDS_WAIT(); __syncthreads();
        const int hl = F.wave >> 1, h = kvh * 4 + hl;
        const float sinkv = biasT[16 * 272 + h];
        for (int sbi = 0; sbi < 2; ++sbi) {
            const int qs = 2 * (F.wave & 1) + sbi, qo = qs * 32;
            bf16x8 qr[4];
#pragma unroll
            for (int ds = 0; ds < 4; ++ds) qr[ds] = *(const bf16x8*)(Q + (size_t)(row0 + qo + r32) * D + h * 64 + ds * 16 + 8 * hh);
            float mref = sinkv, lpart = hh == 0 ? 1.0f : 0.0f;
            f32x16 o[2]; o[0] = f32x16{}; o[1] = f32x16{};
            const int kt0 = qs >> 1;
            for (int t = 0; t < 5; ++t) {
                const int jb = 64 * (kt0 + t);
                f32x16 pA = f32x16{}, pB = f32x16{};
#pragma unroll
                for (int ds = 0; ds < 4; ++ds) {
                    const bf16x8 a0 = *(const LAS bf16x8*)(Kl + (2 * ds + hh) * AT_KSTRIDE + (jb + r32) * 16);
                    const bf16x8 a1 = *(const LAS bf16x8*)(Kl + (2 * ds + hh) * AT_KSTRIDE + (jb + 32 + r32) * 16);
                    pA = __builtin_amdgcn_mfma_f32_32x32x16_bf16(a0, qr[ds], pA, 0, 0, 0);
                    pB = __builtin_amdgcn_mfma_f32_32x32x16_bf16(a1, qr[ds], pB, 0, 0, 0);
                }
                const LAS float* bb = Bl + hl * 512 + jb - qo - r32 + 128 + 4 * hh;
#pragma unroll
                for (int r = 0; r < 16; ++r) { const int cr = (r & 3) + 8 * (r >> 2); pA[r] += bb[cr]; pB[r] += bb[32 + cr]; }
                if (edge) {
#pragma unroll
                    for (int r = 0; r < 16; ++r) { const int j = jb + crow(r, hh); if (j < jlo || j >= jhi) pA[r] = -INFINITY; if (j + 32 < jlo || j + 32 >= jhi) pB[r] = -INFINITY; }
                }
                float rm = fmaxf(pA[0], pB[0]);
#pragma unroll
                for (int r = 1; r < 16; ++r) rm = fmaxf(rm, fmaxf(pA[r], pB[r]));
                rm = swap_max(rm);
                if (__any(rm > mref + ATT_THR)) {
                    const float mn = fmaxf(mref, rm), alpha = __builtin_amdgcn_exp2f(mref - mn);
                    lpart *= alpha; mref = mn;
                    if (hh == 0) wsf[r32] = alpha;
                    LDS_WAIT();
#pragma unroll
                    for (int r = 0; r < 16; ++r) { const float a = wsf[crow(r, hh)]; o[0][r] *= a; o[1][r] *= a; }
                    LDS_WAIT();
                }
                float ls = 0.f;
#pragma unroll
                for (int r = 0; r < 16; ++r) { pA[r] = __builtin_amdgcn_exp2f(pA[r] - mref); pB[r] = __builtin_amdgcn_exp2f(pB[r] - mref); ls += pA[r] + pB[r]; }
                lpart += ls;
                v4u pw[4];
                pw[0] = (v4u){cvt_pk_bf16(pA[0], pA[1]), cvt_pk_bf16(pA[2], pA[3]), cvt_pk_bf16(pA[4], pA[5]), cvt_pk_bf16(pA[6], pA[7])};
                pw[1] = (v4u){cvt_pk_bf16(pA[8], pA[9]), cvt_pk_bf16(pA[10], pA[11]), cvt_pk_bf16(pA[12], pA[13]), cvt_pk_bf16(pA[14], pA[15])};
                pw[2] = (v4u){cvt_pk_bf16(pB[0], pB[1]), cvt_pk_bf16(pB[2], pB[3]), cvt_pk_bf16(pB[4], pB[5]), cvt_pk_bf16(pB[6], pB[7])};
                pw[3] = (v4u){cvt_pk_bf16(pB[8], pB[9]), cvt_pk_bf16(pB[10], pB[11]), cvt_pk_bf16(pB[12], pB[13]), cvt_pk_bf16(pB[14], pB[15])};
                const lds_cptr vb = (lds_cptr)Vl + (jb >> 4) * 2048 + (4 * hh + tq) * 64 + (16 * g + 4 * tp) * 2;
#pragma unroll
                for (int ks = 0; ks < 4; ++ks)
#pragma unroll
                    for (int dh = 0; dh < 2; ++dh) {
                        const lds_cptr a = vb + ks * 2048 + dh * 1024;
                        const s16x4 t0 = vtr(a), t1 = vtr(a + 512);
                        const bf16x8 vf = (bf16x8){t0[0], t0[1], t0[2], t0[3], t1[0], t1[1], t1[2], t1[3]};
                        o[dh] = __builtin_amdgcn_mfma_f32_32x32x16_bf16(__builtin_bit_cast(bf16x8, pw[ks]), vf, o[dh], 0, 0, 0);
                    }
            }
            const float ltot = swap_sum(lpart);
            if (hh == 0) wsf[32 + r32] = ltot;
            LDS_WAIT();
#pragma unroll
            for (int r = 0; r < 16; ++r) { const float rl = 1.0f / wsf[32 + crow(r, hh)];
                stg[crow(r, hh) * 64 + r32] = (unsigned short)f2bf(o[0][r] * rl); stg[crow(r, hh) * 64 + 32 + r32] = (unsigned short)f2bf(o[1][r] * rl); }
            LDS_WAIT();
#pragma unroll
            for (int i = 0; i < 4; ++i) { const int row = i * 8 + (lane >> 3), ch = lane & 7;
                const v4u v = *(const LAS v4u*)((LAS unsigned char*)stg + row * 128 + ch * 16);
                const size_t off = (size_t)(row0 + qo + row) * D + h * 64 + ch * 8;
                const v4u gt = *(const v4u*)(SG + off); v4u w;
                w.x = pk2(bflo(v.x) * bflo(gt.x), bfhi(v.x) * bfhi(gt.x)); w.y = pk2(bflo(v.y) * bflo(gt.y), bfhi(v.y) * bfhi(gt.y));
                w.z = pk2(bflo(v.z) * bflo(gt.z), bfhi(v.z) * bfhi(gt.z)); w.w = pk2(bflo(v.w) * bflo(gt.w), bfhi(v.w) * bfhi(gt.w));
                *(v4u*)(OG + off) = w; }
            LDS_WAIT();
        }
    }
}

__device__ __forceinline__ void final_norm(Frame& F) {
    const float* ss = (const float*)(F.ws + WS_SS2);
    const int gw = F.vcu * NWAVES + F.wave, NGW = F.G * NWAVES;
    for (int m = gw; m < TT; m += NGW) {
        float s = F.lane < 16 ? ss[(size_t)m * 16 + F.lane] : 0.f; s = wave_sum(s);
        const float inv = 1.0f / sqrtf(s * (1.0f / D) + RMS_EPS);
        GAS f32x4* xr = (GAS f32x4*)(F.out + (size_t)m * D) + F.lane; const GAS f32x4* gr = (const GAS f32x4*)F.gf + F.lane;
#pragma unroll
        for (int j = 0; j < 4; ++j) { const f32x4 v = xr[64 * j], g = gr[64 * j]; xr[64 * j] = v * inv * g; }
    }
}

struct Args { const float* in[11]; float* out; unsigned char* ws; int ph_lo, ph_hi; };
__global__ void __launch_bounds__(NTHR, 2) mk_fwd(Args args) {
    extern __shared__ __attribute__((aligned(16))) unsigned char lds[];
    Frame F;
    F.lds = (LAS unsigned char*)lds;
    F.MISC = (volatile LAS unsigned*)(F.lds + MISC_OFF);
    F.tid = threadIdx.x; F.lane = F.tid & 63; F.wave = __builtin_amdgcn_readfirstlane(F.tid >> 6);
    F.G = gridDim.x; { const int bx = blockIdx.x; F.vcu = (F.G % 8 == 0) ? (bx % 8) * (F.G / 8) + bx / 8 : bx; }
    F.ws = args.ws; F.ctl = (gu32*)(args.ws + WS_CTL); F.out = args.out;
    F.xp = args.in[0]; F.xs = args.in[1]; F.relb = args.in[2]; F.g1 = args.in[3]; F.win = args.in[4]; F.wo = args.in[5]; F.sink = args.in[6];
    F.g2 = args.in[7]; F.wg = args.in[8]; F.wo2 = args.in[9]; F.gf = args.in[10];
    for (int u = F.tid; u < (LDS_BYTES - LDSCTL_OFF) / 4; u += NTHR) ((LAS unsigned*)(F.lds + LDSCTL_OFF))[u] = 0u;
    __syncthreads();
    const int lo = args.ph_lo, hi = args.ph_hi;
    XcdBarrier bar; bar.bar = (unsigned*)(F.ctl + CW_BAR); bar.x = 0; bar.st = nullptr;
    if (hi - lo > 1) bar = xcd_barrier_post((unsigned*)(F.ctl + CW_BAR), F.MISC + 8);
#define IN(k) (lo <= (k) && (k) < hi)
#define SEAM(k) do { if (IN(k) && IN((k) + 1)) xcd_barrier(bar); } while (0)
    unsigned char* ws = args.ws;
    bf16* XB = (bf16*)(ws + WS_XB); bf16* Qb = (bf16*)(ws + WS_Q); bf16* Kb = (bf16*)(ws + WS_K); bf16* Vb = (bf16*)(ws + WS_V); bf16* SG = (bf16*)(ws + WS_SG);
    bf16* ZY = (bf16*)(ws + WS_ZY);
    float* inv0 = (float*)(ws + WS_TAB + TAB_INV0); float* ss1 = (float*)(ws + WS_SS1); float* ss2 = (float*)(ws + WS_SS2);

    if (IN(0)) { p0_prologue(F); } SEAM(0);
    if (IN(1)) {
        pg8::Gemm g{XB, (const bf16*)(ws + WS_WIN), TT, INW, D, D, D, 0}; pg8::StaticOrder S; S.init(TT, INW, F.G, (int)blockIdx.x);
        EpiInProj E{Qb, Kb, Vb, SG, inv0};
        pg8::gemm_phase<EpiInProj, pg8::StaticOrder, true>(F.lds + RING_OFF, g, S, E);
    } SEAM(1);
    if (IN(2)) { if (USE_MFMA_ATTN) attn_mfma(F); else attn_naive(F); } SEAM(2);
    if (IN(3)) {
        pg8::Gemm g{XB, (const bf16*)(ws + WS_WO), TT, D, D, D, D, 0}; pg8::StaticOrder S; S.init(TT, D, F.G, (int)blockIdx.x);
        EpiResid E{F.xp, F.xs, 0, F.out, Qb, ss1};
        pg8::gemm_phase<EpiResid, pg8::StaticOrder, true>(F.lds + RING_OFF, g, S, E);
    } SEAM(3);
    if (IN(4)) {
        { pg8::Gemm g{Qb, (const bf16*)(ws + WS_WG), TT, D, D, D, D, 0}; pg8::StaticOrder S; S.init(TT, D, F.G, (int)blockIdx.x);
          EpiGate2 E{SG, ss1};
          pg8::gemm_phase<EpiGate2, pg8::StaticOrder, true>(F.lds + RING_OFF, g, S, E); }
        { pg8::Gemm g{Qb, (const bf16*)(ws + WS_WDFT), TT, 2048, 256, D, 256, 2}; pg8::StaticOrder S; S.init(TT, 2048, F.G, (int)blockIdx.x);
          EpiChanDft E{ZY, ss1};
          pg8::gemm_phase<EpiChanDft, pg8::StaticOrder, true>(F.lds + RING_OFF, g, S, E); }
    } SEAM(4);
    if (IN(5)) { if (USE_MFMA_DFT) { stage1_mfma<true>(F); stage1_mfma<false>(F); } else stage1_naive(F); } SEAM(5);
    if (IN(6)) { if (USE_MFMA_DFT) stage2_mfma(F); else stage2_naive(F); } SEAM(6);
    if (IN(7)) {
        pg8::Gemm g{Qb, (const bf16*)(ws + WS_WO2), TT, D, D, D, D, 0}; pg8::StaticOrder S; S.init(TT, D, F.G, (int)blockIdx.x);
        EpiResid E{F.xp, F.xs, 1, F.out, nullptr, ss2};
        pg8::gemm_phase<EpiResid, pg8::StaticOrder, true>(F.lds + RING_OFF, g, S, E);
    } SEAM(7);
    if (IN(8)) { final_norm(F); }
#undef IN
#undef SEAM
}

extern "C" void kernel_launch(void* const* d_in, const int* in_sizes, int n_in, void* d_out, int out_size, void* d_ws, size_t ws_size, hipStream_t stream) {
    static int grid = 0;
    if (grid == 0) {
        if (n_in != 11 || in_sizes[0] != T_PROMPT * D || in_sizes[1] != T_SAMPLE * D || out_size != TT * D || ws_size < WS_END) {
            fprintf(stderr, "kernel_launch: unexpected shapes (n_in %d, in0 %d, in1 %d, out %d, ws %zu); nothing launched\n", n_in, n_in > 0 ? in_sizes[0] : -1, n_in > 1 ? in_sizes[1] : -1, out_size, ws_size); grid = -1; return; }
        int dev = 0, cus = 0, per_cu = 0;
        if (hipGetDevice(&dev) != hipSuccess || hipDeviceGetAttribute(&cus, hipDeviceAttributeMultiprocessorCount, dev) != hipSuccess) { grid = -1; return; }
        if (hipFuncSetAttribute((const void*)mk_fwd, hipFuncAttributeMaxDynamicSharedMemorySize, LDS_BYTES) != hipSuccess) { fprintf(stderr, "kernel_launch: hipFuncSetAttribute failed\n"); grid = -1; return; }
        if (hipOccupancyMaxActiveBlocksPerMultiprocessor(&per_cu, (const void*)mk_fwd, NTHR, LDS_BYTES) != hipSuccess || per_cu < 1) { fprintf(stderr, "kernel_launch: occupancy query says %d blocks per CU\n", per_cu); grid = -1; (void)hipGetLastError(); return; }
        (void)hipGetLastError();
        grid = cus;
    }
    if (grid < 0) return;
    (void)hipMemsetAsync((char*)d_ws + WS_CTL, 0, CTL_ZERO_BYTES, stream);
    Args a{};
    for (int i = 0; i < 11; ++i) a.in[i] = (const float*)d_in[i];
    a.out = (float*)d_out; a.ws = (unsigned char*)d_ws;
#if MK_ONE_LAUNCH
    a.ph_lo = 0; a.ph_hi = NPH;
    hipLaunchKernelGGL(mk_fwd, dim3(grid), dim3(NTHR), LDS_BYTES, stream, a);
#else
    for (int p = 0; p < NPH; ++p) { a.ph_lo = p; a.ph_hi = p + 1; hipLaunchKernelGGL(mk_fwd, dim3(grid), dim3(NTHR), LDS_BYTES, stream, a); }
#endif
}
```

```cpp
#include <hip/hip_runtime.h>
#include <cstdio>
#include <cstdint>

namespace pg8 {
#define PG8_LAS __attribute__((address_space(3)))
typedef unsigned short bf16_t;
typedef short bf16x8 __attribute__((ext_vector_type(8)));
typedef float f32x4 __attribute__((ext_vector_type(4)));
typedef unsigned u32x4 __attribute__((ext_vector_type(4)));
constexpr int BM = 256, BK = 64, HALF = 128, HTB = HALF * BK * 2  , STAGE_BYTES = 8 * HTB, NXCD = 8, WGM = 8;

__host__ __device__ __forceinline__ int lds_byte(int r, int c) { const int st = (r >> 4) * 2 + (c >> 5), rr = r & 15, cc = c & 31, ob = rr * 64 + cc * 2; return st * 1024 + (ob ^ (((ob >> 9) & 1) << 5)); }
__host__ __device__ __forceinline__ void stage_rc(int b, int& R, int& C) { const int st = b / 1024, sb = b % 1024, swz = sb ^ (((sb >> 9) & 1) << 5); R = (st >> 1) * 16 + swz / 64; C = (st & 1) * 32 + (swz % 64) / 2; }
__host__ __device__ __forceinline__ int perm32(int rho) { const int n = rho >> 4, i = rho & 15; return 8 * (i >> 2) + 4 * n + (i & 3); }

struct Unit { int pm, pn; };
struct Gemm { const bf16_t* A; const bf16_t* Bt; int M, N, K, lda, ldb, a_grp; };

struct StaticOrder {
    int nM, nN, nwg, G, c;
    __host__ __device__ void init(int M, int N, int G_, int c_) { nM = M / BM; nN = N / BM; nwg = nM * nN; G = G_; c = c_; }
    __host__ __device__ bool next(int i, Unit& u) const {
        const long L = (long)i * G + c; if (L >= nwg) return false;
        int wgid = (int)L; { const int q = nwg / NXCD, r = nwg % NXCD, xcd = wgid % NXCD, off = wgid / NXCD; wgid = (xcd < r ? xcd * (q + 1) : r * (q + 1) + (xcd - r) * q) + off; }
        const int nig = WGM * nN, gid = wgid / nig, fm = gid * WGM, gsz = (nM - fm) < WGM ? (nM - fm) : WGM;
        u.pm = fm + ((wgid % nig) % gsz); u.pn = (wgid % nig) / gsz; return true;
    }
};

__device__ __forceinline__ unsigned cvt_pk_bf16(float lo, float hi) { unsigned r; asm volatile("v_cvt_pk_bf16_f32 %0, %1, %2" : "=v"(r) : "v"(lo), "v"(hi)); return r; }

template <class Epi, class Sched, bool ALIGN_EPI = false>
__device__ __forceinline__ void gemm_phase(PG8_LAS unsigned char* lds, const Gemm g, const Sched& S, const Epi& E) {
    const int tid = threadIdx.x, wid = __builtin_amdgcn_readfirstlane(tid >> 6), lane = tid & 63, wr = wid >> 2, wc = wid & 3, fr = lane & 15, fq = lane >> 4;
    const int K = g.K, nt = K / BK;
    unsigned voffA[2], voffB[2];
#pragma unroll
    for (int i = 0; i < 2; ++i) { int R, C; stage_rc(tid * 16 + i * 8192, R, C); const int Rb = Epi::PERM ? ((R & ~31) + perm32(R & 31)) : R;
        voffA[i] = (unsigned)(R * g.lda + C) * 2u; voffB[i] = (unsigned)(Rb * g.ldb + C) * 2u; }
    const size_t kstep = (size_t)(BK * 2);
    const size_t hstepA = (size_t)HALF * g.lda * 2, hstepB = (size_t)HALF * g.ldb * 2;
    const size_t tstepA = 2 * hstepA, tstepB = 2 * hstepB;
    const unsigned ldsw = (unsigned)wid * 1024u;
    const int aoff = lds_byte(wr * 64 + fr, fq * 8), boff = lds_byte(wc * 32 + fr, fq * 8);
#define PG8_SA(b, h) (((b) * 2 + (h)) * HTB)
#define PG8_SB(b, h) ((4 + (b) * 2 + (h)) * HTB)
#define PG8_STAGE(bufoff, gbase, voff) do { _Pragma("unroll") for (int _i = 0; _i < 2; ++_i) \
        __builtin_amdgcn_global_load_lds((const unsigned*)((const char*)(gbase) + (voff)[_i]), (PG8_LAS unsigned*)(lds + (bufoff) + ldsw + _i * 8192), 16, 0, 0); } while (0)
#define PG8_LDA(dst, b, h) do { _Pragma("unroll") for (int m = 0; m < 4; ++m) _Pragma("unroll") for (int k = 0; k < 2; ++k) dst[m][k] = *(const PG8_LAS bf16x8*)(lds + PG8_SA(b, h) + aoff + m * 2048 + k * 1024); } while (0)
#define PG8_LDB(dst, b, h) do { _Pragma("unroll") for (int n = 0; n < 2; ++n) _Pragma("unroll") for (int k = 0; k < 2; ++k) dst[n][k] = *(const PG8_LAS bf16x8*)(lds + PG8_SB(b, h) + boff + n * 2048 + k * 1024); } while (0)
#define PG8_MMA(ai, bj, At, Bt) do { __builtin_amdgcn_s_setprio(1); _Pragma("unroll") for (int m = 0; m < 4; ++m) _Pragma("unroll") for (int n = 0; n < 2; ++n) _Pragma("unroll") for (int k = 0; k < 2; ++k) \
        acc[ai][bj][m][n] = __builtin_amdgcn_mfma_f32_16x16x32_bf16(Bt[n][k], At[m][k], acc[ai][bj][m][n], 0, 0, 0); __builtin_amdgcn_s_setprio(0); } while (0)
#define PG8_WAIT_V(n) asm volatile("s_waitcnt vmcnt(" #n ")" ::: "memory")
#define PG8_WAIT_L(n) asm volatile("s_waitcnt lgkmcnt(" #n ")" ::: "memory")
#define PG8_BAR __builtin_amdgcn_s_barrier()
#define PG8_SCHED __builtin_amdgcn_sched_barrier(0)
#define PG8_ABASE(u) ((const char*)g.A + (size_t)(u).pm * tstepA + (g.a_grp ? (size_t)((u).pn / g.a_grp) * (size_t)K * 2 : (size_t)0))
#define PG8_BBASE(u) ((const char*)g.Bt + (size_t)(u).pn * tstepB)
    Unit cur, nxt; int ui = 0;
    if (!S.next(0, cur)) return;
    f32x4 acc[2][2][4][2];
#pragma unroll
    for (int a = 0; a < 2; ++a)
#pragma unroll
        for (int b = 0; b < 2; ++b)
#pragma unroll
            for (int m = 0; m < 4; ++m)
#pragma unroll
                for (int n = 0; n < 2; ++n) acc[a][b][m][n] = (f32x4){0.f, 0.f, 0.f, 0.f};
    bf16x8 At[4][2], B0[2][2], B1[2][2];
    const char* cA = PG8_ABASE(cur); const char* cB = PG8_BBASE(cur);
    PG8_STAGE(PG8_SB(0, 0), cB, voffB); PG8_STAGE(PG8_SB(0, 1), cB + hstepB, voffB); PG8_STAGE(PG8_SA(0, 0), cA, voffA); PG8_STAGE(PG8_SA(0, 1), cA + hstepA, voffA);
    if (wr == 1) PG8_BAR;
    PG8_WAIT_V(2); PG8_BAR;
    PG8_STAGE(PG8_SB(1, 0), cB + kstep, voffB); PG8_STAGE(PG8_SA(1, 0), cA + kstep, voffA); PG8_STAGE(PG8_SB(1, 1), cB + hstepB + kstep, voffB);
    PG8_WAIT_V(6); PG8_BAR;
    for (;;) {
        const bool has_next = S.next(ui + 1, nxt);
        const char* nA = has_next ? PG8_ABASE(nxt) : cA; const char* nB = has_next ? PG8_BBASE(nxt) : cB;
        for (int t = 0; t < nt; t += 2) {
            const bool last = (t == nt - 2);
            const char* a1 = cA + (size_t)(t + 1) * kstep;
            const char* a2 = last ? nA : cA + (size_t)(t + 2) * kstep; const char* b2 = last ? nB : cB + (size_t)(t + 2) * kstep;
            const char* a3 = a2 + kstep; const char* b3 = b2 + kstep;
            PG8_LDB(B0, 0, 0); PG8_LDB(B1, 0, 1); PG8_SCHED; PG8_LDA(At, 0, 0); PG8_STAGE(PG8_SA(1, 1), a1 + hstepA, voffA);
            PG8_WAIT_V(8); PG8_WAIT_L(0); PG8_BAR; PG8_MMA(0, 0, At, B0); PG8_MMA(0, 1, At, B1); PG8_BAR; PG8_SCHED;
            PG8_LDA(At, 0, 1); PG8_STAGE(PG8_SB(0, 0), b2, voffB); PG8_STAGE(PG8_SB(0, 1), b2 + hstepB, voffB); PG8_STAGE(PG8_SA(0, 0), a2, voffA);
            PG8_WAIT_V(8); PG8_WAIT_L(0); PG8_BAR; PG8_MMA(1, 0, At, B0); PG8_MMA(1, 1, At, B1); PG8_BAR; PG8_SCHED;
            PG8_LDB(B0, 1, 0); PG8_LDB(B1, 1, 1); PG8_SCHED; PG8_LDA(At, 1, 0); PG8_STAGE(PG8_SA(0, 1), a2 + hstepA, voffA);
            PG8_WAIT_V(8); PG8_WAIT_L(0); PG8_BAR; PG8_MMA(0, 0, At, B0); PG8_MMA(0, 1, At, B1); PG8_BAR; PG8_SCHED;
            PG8_LDA(At, 1, 1); PG8_STAGE(PG8_SB(1, 0), b3, voffB); PG8_STAGE(PG8_SB(1, 1), b3 + hstepB, voffB); PG8_STAGE(PG8_SA(1, 0), a3, voffA);
            PG8_WAIT_V(8); PG8_WAIT_L(0); PG8_BAR; PG8_MMA(1, 0, At, B0); PG8_MMA(1, 1, At, B1); PG8_BAR; PG8_SCHED;
        }
        if constexpr (ALIGN_EPI) { if (wr == 0) PG8_BAR; }
        E(acc, cur, wr, wc, fr, fq);
        if (!has_next) break;
#pragma unroll
        for (int a = 0; a < 2; ++a)
#pragma unroll
            for (int b = 0; b < 2; ++b)
#pragma unroll
                for (int m = 0; m < 4; ++m)
#pragma unroll
                    for (int n = 0; n < 2; ++n) acc[a][b][m][n] = (f32x4){0.f, 0.f, 0.f, 0.f};
        cur = nxt; cA = nA; cB = nB; ++ui;
        if constexpr (ALIGN_EPI) { if (wr == 1) PG8_BAR; }
    }
    PG8_WAIT_V(0);
    if constexpr (!ALIGN_EPI) { if (wr == 0) PG8_BAR; }
    PG8_BAR;
#undef PG8_SA
#undef PG8_SB
#undef PG8_STAGE
#undef PG8_LDA
#undef PG8_LDB
#undef PG8_MMA
#undef PG8_WAIT_V
#undef PG8_WAIT_L
#undef PG8_BAR
#undef PG8_SCHED
#undef PG8_ABASE
#undef PG8_BBASE
}
}

constexpr int NWAVES = 8, NTHR = 512;
#ifndef USE_MFMA_ATTN
#define USE_MFMA_ATTN 1
#endif
#ifndef USE_MFMA_DFT
#define USE_MFMA_DFT 1
#endif
#ifndef PROBE_REPEAT
#define PROBE_REPEAT -1
#endif
#define REP(k) for (int rep_ = 0; rep_ < ((PROBE_REPEAT == (k)) ? 2 : 1); ++rep_)
#ifndef MK_ONE_LAUNCH
#define MK_ONE_LAUNCH 1
#endif
constexpr int D = 1024;
constexpr int T_PROMPT = 2 * 16384, T_SAMPLE = 4 * 4096, TT = T_PROMPT + T_SAMPLE;
constexpr int NSEQ = 6;
constexpr int NH = 16, NKV = 4, HD = 64, KVW = 256, INW = 2560;
constexpr float RMS_EPS = 1e-6f;
constexpr float LOG2E = 1.4426950408889634f;
constexpr float QSCALE = 0.125f * LOG2E;
constexpr int N2 = 128;
constexpr int NPH = 9;

__host__ __device__ __forceinline__ int seq_base(int s) { return s < 2 ? s * 16384 : T_PROMPT + (s - 2) * 4096; }
__host__ __device__ __forceinline__ int seq_len(int s) { return s < 2 ? 16384 : 4096; }

constexpr size_t MiB = 1u << 20;
constexpr size_t WS_CTL = 0, CTL_ZERO_BYTES = 1 * MiB;
constexpr size_t WS_WIN = 1 * MiB;
constexpr size_t WS_WO = 6 * MiB;
constexpr size_t WS_WG = 8 * MiB;
constexpr size_t WS_WO2 = 10 * MiB;
constexpr size_t WS_WDFT = 12 * MiB;
constexpr size_t WS_TAB = 13 * MiB;
constexpr size_t TAB_A1P = 0;
constexpr size_t TAB_A1S = 128 * 1024;
constexpr size_t TAB_A2 = 144 * 1024;
constexpr size_t TAB_BIAS = 208 * 1024;
constexpr size_t TAB_INV0 = 256 * 1024;
constexpr size_t WS_SS1 = 14 * MiB;
constexpr size_t WS_SS2 = 17 * MiB;
constexpr size_t WS_ZY = 20 * MiB;
constexpr size_t WS_XB = 20 * MiB;
constexpr size_t WS_K = 116 * MiB;
constexpr size_t WS_V = 140 * MiB;
constexpr size_t WS_Q = 212 * MiB;
constexpr size_t WS_SG = 308 * MiB;
constexpr size_t WS_U = 404 * MiB;
constexpr size_t WS_END = 500 * MiB;
constexpr int CW_BAR = 4096;

constexpr int RING_OFF = 0, RING_BYTES = 162816;
constexpr int LDSCTL_OFF = RING_BYTES, MISC_OFF = LDSCTL_OFF + 320;
constexpr int LDS_BYTES = 163840;

#define GAS __attribute__((address_space(1)))
#define LAS __attribute__((address_space(3)))
typedef unsigned short bf16;
typedef unsigned v4u __attribute__((ext_vector_type(4)));
typedef unsigned v2u __attribute__((ext_vector_type(2)));
typedef float f32x4 __attribute__((ext_vector_type(4)));
typedef GAS unsigned gu32;
#define RLX_AGENT __ATOMIC_RELAXED, __HIP_MEMORY_SCOPE_AGENT
#define LDS_WAIT() asm volatile("s_waitcnt lgkmcnt(0)" ::: "memory")
#define VM_WAIT() asm volatile("s_waitcnt vmcnt(0)" ::: "memory")
__device__ __forceinline__ unsigned f2bf(float f) { unsigned u = __builtin_bit_cast(unsigned, f); return (u + 0x7fffu + ((u >> 16) & 1u)) >> 16; }
__device__ __forceinline__ unsigned pk2(float lo, float hi) { return f2bf(lo) | (f2bf(hi) << 16); }
__device__ __forceinline__ float bf2f(unsigned short b) { return __builtin_bit_cast(float, (unsigned)b << 16); }
__device__ __forceinline__ float bflo(unsigned w) { return __builtin_bit_cast(float, w << 16); }
__device__ __forceinline__ float bfhi(unsigned w) { return __builtin_bit_cast(float, w & 0xffff0000u); }
__device__ __forceinline__ float silu_f(float x) { return x * __builtin_amdgcn_rcpf(1.0f + __builtin_amdgcn_exp2f(-x * LOG2E)); }

#define XB_TMO      128
#define XB_XCNT(j)  (256  + 64 * (j))
#define XB_XSUB(j)  (1280 + 64 * (j))
#define XB_XGEN(j)  (2304 + 64 * (j))
#define XB_TOP      3328
#define XB_TOPGEN   3392
#define XCD_BAR_WORDS 3456
#define XB_SPIN_CAP (1u << 18)
__device__ __forceinline__ unsigned xb_ld(unsigned* p)              { return __hip_atomic_load(p, __ATOMIC_RELAXED, __HIP_MEMORY_SCOPE_AGENT); }
__device__ __forceinline__ unsigned xb_add(unsigned* p, unsigned v) { return __hip_atomic_fetch_add(p, v, __ATOMIC_RELAXED, __HIP_MEMORY_SCOPE_AGENT); }
__device__ __forceinline__ unsigned xb_xcc_id() { return (unsigned)__builtin_amdgcn_s_getreg((3 << 11) | 20) & 0xFu; }
#define XB_SPIN(cond, bar) do { unsigned _sp = 0; while (cond) { __builtin_amdgcn_s_sleep(1); \
    if ((++_sp & 255u) == 0u) { if (xb_ld(&(bar)[XB_TMO])) break; if (_sp > XB_SPIN_CAP) { atomicAdd(&(bar)[XB_TMO], 1u); break; } } } } while (0)
struct XcdBarrier { unsigned* bar; unsigned x; volatile LAS unsigned* st; };
__device__ __forceinline__ XcdBarrier xcd_barrier_post(unsigned* bar, volatile LAS unsigned* st) {
    XcdBarrier b; b.bar = bar; b.x = xb_xcc_id(); b.st = st;
    if (threadIdx.x == 0) (void)xb_add(&bar[XB_XCNT(b.x)], 1u);
    return b;
}
__device__ __forceinline__ void xcd_barrier_complete(unsigned* bar, unsigned x, unsigned& nloc, unsigned& nx) {
    const unsigned G = gridDim.x * gridDim.y * gridDim.z;
    unsigned sum, cnt, mine, sp = 0u;
    for (;;) {
        sum = 0u; cnt = 0u; mine = 0u;
#pragma unroll
        for (unsigned j = 0; j < 16; ++j) { const unsigned c = xb_ld(&bar[XB_XCNT(j)]); sum += c; cnt += (c > 0u) ? 1u : 0u; mine = (j == x) ? c : mine; }
        if (sum == G) break;
        __builtin_amdgcn_s_sleep(1);
        if ((++sp & 255u) == 0u) { if (xb_ld(&bar[XB_TMO])) break; if (sp > XB_SPIN_CAP) { atomicAdd(&bar[XB_TMO], 1u); break; } }
    }
    nloc = mine > 0u ? mine : 1u; nx = cnt > 0u ? cnt : 1u;
}
__device__ __forceinline__ void xcd_barrier(const XcdBarrier& b) {
    asm volatile("s_waitcnt vmcnt(0)" ::: "memory");
    __syncthreads();
    if (threadIdx.x == 0) {
        unsigned* bar = b.bar;
        __builtin_amdgcn_s_waitcnt(0);
        unsigned nloc = b.st[0], nx = b.st[1];
        if (nloc == 0u) { xcd_barrier_complete(bar, b.x, nloc, nx); b.st[0] = nloc; b.st[1] = nx; }
        const unsigned old = xb_add(&bar[XB_XSUB(b.x)], 1u);
        const unsigned gen = old / nloc;
        if (old + 1u == (gen + 1u) * nloc) {
            __builtin_amdgcn_fence(__ATOMIC_RELEASE, "agent");
            asm volatile("s_waitcnt vmcnt(0)" ::: "memory");
            const unsigned og = xb_add(&bar[XB_TOP], 1u);
            const unsigned tg = og / nx;
            if (og + 1u == (tg + 1u) * nx) xb_add(&bar[XB_TOPGEN], 1u);
            else XB_SPIN(xb_ld(&bar[XB_TOPGEN]) == tg, bar);
            __builtin_amdgcn_fence(__ATOMIC_ACQUIRE, "agent");
            xb_add(&bar[XB_XGEN(b.x)], 1u);
            asm volatile("s_waitcnt vmcnt(0)" ::: "memory");
        } else {
            XB_SPIN(xb_ld(&bar[XB_XGEN(b.x)]) == gen, bar);
            __builtin_amdgcn_fence(__ATOMIC_ACQUIRE, "agent");
            asm volatile("s_waitcnt vmcnt(0)" ::: "memory");
        }
    }
    __syncthreads();
}

struct Frame {
    LAS unsigned char* lds;
    volatile LAS unsigned* MISC;
    gu32* ctl;
    int tid, lane, wave, vcu, G;
    const float *xp, *xs, *relb, *g1, *win, *wo, *sink, *g2, *wg, *wo2, *gf;
    float* out;
    unsigned char* ws;
};
__device__ __forceinline__ const float* xin_row(const Frame& F, int row) { return row < T_PROMPT ? F.xp + (size_t)row * D : F.xs + (size_t)(row - T_PROMPT) * D; }
__device__ __forceinline__ float wave_sum(float v) {
#pragma unroll
    for (int o = 1; o < 64; o <<= 1) v += __shfl_xor(v, o);
    return v;
}

__device__ __forceinline__ void p0_transpose_item(const float* W, const float* gain, int K, int N, bf16* WT, LAS float* scr, int item, int lane) {
    const int nblk = N / 32, kb = item / nblk, nb = item % nblk, k0 = 64 * kb, n0 = 32 * nb;
#pragma unroll 8
    for (int i = 0; i < 32; ++i) { const int kk = 2 * i + (lane >> 5); const float gv = gain ? gain[k0 + kk] : 1.0f; scr[kk * 33 + (lane & 31)] = gv * W[(size_t)(k0 + kk) * N + n0 + (lane & 31)]; }
    LDS_WAIT(); asm volatile("" ::: "memory");
    const int c = lane & 7;
#pragma unroll
    for (int j = 0; j < 4; ++j) { const int n = (lane >> 3) + 8 * j; const LAS float* s = scr + (8 * c) * 33 + n;
        v4u o; o.x = pk2(s[0 * 33], s[1 * 33]); o.y = pk2(s[2 * 33], s[3 * 33]); o.z = pk2(s[4 * 33], s[5 * 33]); o.w = pk2(s[6 * 33], s[7 * 33]);
        *(GAS v4u*)(WT + (size_t)(n0 + n) * K + k0 + 8 * c) = o; }
    LDS_WAIT(); asm volatile("" ::: "memory");
}
__host__ __device__ __forceinline__ void m_to_k1part(int m, int& k1, int& part) { const int w = m >> 5, j = m & 31; part = (j >> 3) & 1; k1 = 16 * w + (j & 7) + 8 * (j >> 4); }
__host__ __device__ __forceinline__ int t5_bucket(int rel) {
    const int n = -rel; const int a = n < 0 ? -n : n;
    const int b = a < 8 ? a : (a < 12 ? 8 : a < 16 ? 9 : a < 23 ? 10 : a < 32 ? 11 : a < 46 ? 12 : a < 64 ? 13 : a < 91 ? 14 : 15);
    return (n < 0 ? 16 : 0) + b;
}
__device__ __forceinline__ void p0_prologue(Frame& F) {
    LAS float* scr = (LAS float*)(F.lds + RING_OFF + F.wave * 16384);
    const int gw = F.vcu * NWAVES + F.wave, NGW = F.G * NWAVES;
    constexpr int I_IN = (D / 64) * (INW / 32), I_SQ = (D / 64) * (D / 32);
    constexpr int NITEMS = I_IN + 3 * I_SQ;
    bf16* win_t = (bf16*)(F.ws + WS_WIN); bf16* wo_t = (bf16*)(F.ws + WS_WO); bf16* wg_t = (bf16*)(F.ws + WS_WG); bf16* wo2_t = (bf16*)(F.ws + WS_WO2);
    for (int it = gw; it < NITEMS; it += NGW) {
        int r = it;
        if (r < I_IN) { p0_transpose_item(F.win, F.g1, D, INW, win_t, scr, r, F.lane); continue; } r -= I_IN;
        if (r < I_SQ) { p0_transpose_item(F.wo, nullptr, D, D, wo_t, scr, r, F.lane); continue; } r -= I_SQ;
        if (r < I_SQ) { p0_transpose_item(F.wg, F.g2, D, D, wg_t, scr, r, F.lane); continue; } r -= I_SQ;
        p0_transpose_item(F.wo2, nullptr, D, D, wo2_t, scr, r, F.lane);
    }
    const int gt = (F.vcu * NTHR) + F.tid, NGT = F.G * NTHR;
    bf16* wdft = (bf16*)(F.ws + WS_WDFT);
    for (int e = gt; e < 2048 * 256; e += NGT) {
        const int np = e >> 8, c = e & 255, g = np >> 9, ri = (np >> 8) & 1, cp = np & 255;
        const int t = (c * cp) & 255; float sn, cs; sincospif((float)t * (1.0f / 128.0f), &sn, &cs);
        const float v = F.g2[g * 256 + c] * (ri ? -sn : cs) * (1.0f / 16.0f);
        wdft[e] = (bf16)f2bf(v);
    }
    bf16* a1p = (bf16*)(F.ws + WS_TAB + TAB_A1P);
    for (int e = gt; e < 256 * 256; e += NGT) {
        const int m = e >> 8, k = e & 255, ri = k >> 7, s1 = k & 127; int k1, part; m_to_k1part(m, k1, part);
        const int t = (s1 * k1) & 127; float sn, cs; sincospif((float)t * (1.0f / 64.0f), &sn, &cs);
        const float v = (part == 0 ? (ri == 0 ? cs : sn) : (ri == 0 ? -sn : cs)) * 0.08838834764831845f;
        a1p[e] = (bf16)f2bf(v);
    }
    bf16* a1s = (bf16*)(F.ws + WS_TAB + TAB_A1S);
    for (int e = gt; e < 64 * 64; e += NGT) {
        const int m = e >> 6, k = e & 63, ri = k >> 5, s1 = k & 31; int k1, part; m_to_k1part(m, k1, part);
        const int t = (s1 * k1) & 31; float sn, cs; sincospif((float)t * (1.0f / 16.0f), &sn, &cs);
        const float v = (part == 0 ? (ri == 0 ? cs : sn) : (ri == 0 ? -sn : cs)) * 0.17677669529663687f;
        a1s[e] = (bf16)f2bf(v);
    }
    bf16* a2 = (bf16*)(F.ws + WS_TAB + TAB_A2);
    for (int e = gt; e < 128 * 256; e += NGT) {
        const int k2 = e >> 8, k = e & 255, ri = k >> 7, s2 = k & 127;
        const int t = (s2 * k2) & 127; float sn, cs; sincospif((float)t * (1.0f / 64.0f), &sn, &cs);
        a2[e] = (bf16)f2bf((ri == 0 ? cs : sn) * 0.08838834764831845f);
    }
    float* biasT = (float*)(F.ws + WS_TAB + TAB_BIAS);
    for (int e = gt; e < 16 * 272 + 16; e += NGT) {
        if (e < 16 * 272) { const int h = e / 272, r = e % 272; const int rel = (r > 256 ? 256 : r) - 128; biasT[e] = F.relb[t5_bucket(rel) * NH + h] * LOG2E; }
        else biasT[e] = F.sink[e - 16 * 272] * LOG2E;
    }
    bf16* xb = (bf16*)(F.ws + WS_XB); float* inv0 = (float*)(F.ws + WS_TAB + TAB_INV0);
    for (int m = gw; m < TT; m += NGW) {
        const GAS f32x4* xr = (const GAS f32x4*)xin_row(F, m) + F.lane;
        f32x4 v[4]; float s = 0.f;
#pragma unroll
        for (int j = 0; j < 4; ++j) { v[j] = xr[64 * j]; s += (v[j].x * v[j].x + v[j].y * v[j].y) + (v[j].z * v[j].z + v[j].w * v[j].w); }
        s = wave_sum(s);
        if (F.lane == 0) inv0[m] = 1.0f / sqrtf(s * (1.0f / D) + RMS_EPS);
        GAS v2u* o8 = (GAS v2u*)(xb + (size_t)m * D) + F.lane;
#pragma unroll
        for (int j = 0; j < 4; ++j) { v2u w; w.x = pk2(v[j].x, v[j].y); w.y = pk2(v[j].z, v[j].w); o8[64 * j] = w; }
    }
}

using pg8::cvt_pk_bf16;
typedef pg8::f32x4 accv;
#define EPI_ROW(u, ai, m) ((u).pm * 256 + (ai) * 128 + wr * 64 + (m) * 16 + fr)
#define EPI_COL(bj) ((bj) * 128 + wc * 32 + 8 * fq)
__device__ __forceinline__ v4u pack8(accv a, accv b) { v4u w; w.x = cvt_pk_bf16(a[0], a[1]); w.y = cvt_pk_bf16(a[2], a[3]); w.z = cvt_pk_bf16(b[0], b[1]); w.w = cvt_pk_bf16(b[2], b[3]); return w; }
__device__ __forceinline__ accv silu4(accv v) { accv o; o[0] = silu_f(v[0]); o[1] = silu_f(v[1]); o[2] = silu_f(v[2]); o[3] = silu_f(v[3]); return o; }

struct EpiInProj {
    static constexpr bool PERM = true;
    bf16 *Q, *Kb, *Vb, *SG; const float* inv0;
    __device__ __forceinline__ void operator()(const accv (&acc)[2][2][4][2], const pg8::Unit& u, int wr, int wc, int fr, int fq) const {
        const int pn = u.pn;
#pragma unroll
        for (int ai = 0; ai < 2; ++ai)
#pragma unroll
            for (int m = 0; m < 4; ++m) {
                const int row = EPI_ROW(u, ai, m); const float inv = inv0[row];
#pragma unroll
                for (int bj = 0; bj < 2; ++bj) {
                    accv v0 = acc[ai][bj][m][0] * inv, v1 = acc[ai][bj][m][1] * inv; const int col = EPI_COL(bj);
                    if (pn < 4) { v0 = v0 * QSCALE; v1 = v1 * QSCALE; *(v4u*)(Q + (size_t)row * D + pn * 256 + col) = pack8(v0, v1); }
                    else if (pn == 4) { *(v4u*)(Kb + (size_t)row * KVW + col) = pack8(v0, v1); }
                    else if (pn == 5) { *(v4u*)(Vb + (size_t)row * KVW + col) = pack8(v0, v1); }
                    else { *(v4u*)(SG + (size_t)row * D + (pn - 6) * 256 + col) = pack8(silu4(v0), silu4(v1)); }
                }
            }
    }
};
struct EpiResid1 {
    static constexpr bool PERM = true;
    const float* xp; const float* xs; bf16* xb; float* ss;
    __device__ __forceinline__ void operator()(const accv (&acc)[2][2][4][2], const pg8::Unit& u, int wr, int wc, int fr, int fq) const {
        const int pn = u.pn;
#pragma unroll
        for (int ai = 0; ai < 2; ++ai)
#pragma unroll
            for (int m = 0; m < 4; ++m) {
                const int row = EPI_ROW(u, ai, m);
                const float* src = row < T_PROMPT ? xp + (size_t)row * D : xs + (size_t)(row - T_PROMPT) * D;
                float q = 0.f;
#pragma unroll
                for (int bj = 0; bj < 2; ++bj) {
                    const int col = pn * 256 + EPI_COL(bj);
                    const accv r0 = *(const accv*)(src + col), r1 = *(const accv*)(src + col + 4);
                    const accv v0 = acc[ai][bj][m][0] + r0, v1 = acc[ai][bj][m][1] + r1;
                    q += (v0[0] * v0[0] + v0[1] * v0[1]) + (v0[2] * v0[2] + v0[3] * v0[3]) + (v1[0] * v1[0] + v1[1] * v1[1]) + (v1[2] * v1[2] + v1[3] * v1[3]);
                    *(v4u*)(xb + (size_t)row * D + col) = pack8(v0, v1);
                }
                q += __shfl_xor(q, 16); q += __shfl_xor(q, 32);
                if (fq == 0) ss[(size_t)row * 16 + pn * 4 + wc] = q;
            }
    }
};
struct EpiResid2 {
    static constexpr bool PERM = true;
    const bf16* x1b; float* out; float* ss;
    __device__ __forceinline__ void operator()(const accv (&acc)[2][2][4][2], const pg8::Unit& u, int wr, int wc, int fr, int fq) const {
        const int pn = u.pn;
#pragma unroll
        for (int ai = 0; ai < 2; ++ai)
#pragma unroll
            for (int m = 0; m < 4; ++m) {
                const int row = EPI_ROW(u, ai, m);
                float q = 0.f;
#pragma unroll
                for (int bj = 0; bj < 2; ++bj) {
                    const int col = pn * 256 + EPI_COL(bj);
                    const v4u rb = *(const v4u*)(x1b + (size_t)row * D + col);
                    const accv r0 = (accv){bflo(rb.x), bfhi(rb.x), bflo(rb.y), bfhi(rb.y)}, r1 = (accv){bflo(rb.z), bfhi(rb.z), bflo(rb.w), bfhi(rb.w)};
                    const accv v0 = acc[ai][bj][m][0] + r0, v1 = acc[ai][bj][m][1] + r1;
                    q += (v0[0] * v0[0] + v0[1] * v0[1]) + (v0[2] * v0[2] + v0[3] * v0[3]) + (v1[0] * v1[0] + v1[1] * v1[1]) + (v1[2] * v1[2] + v1[3] * v1[3]);
                    *(accv*)(out + (size_t)row * D + col) = v0; *(accv*)(out + (size_t)row * D + col + 4) = v1;
                }
                q += __shfl_xor(q, 16); q += __shfl_xor(q, 32);
                if (fq == 0) ss[(size_t)row * 16 + pn * 4 + wc] = q;
            }
    }
};
__device__ __forceinline__ float inv_from_ss(const float* ss, int row, int fq) {
    const accv p = *(const accv*)(ss + (size_t)row * 16 + fq * 4);
    float s = (p[0] + p[1]) + (p[2] + p[3]); s += __shfl_xor(s, 16); s += __shfl_xor(s, 32);
    return 1.0f / sqrtf(s * (1.0f / D) + RMS_EPS);
}
struct EpiGate2 {
    static constexpr bool PERM = true;
    bf16* SG; const float* ss;
    __device__ __forceinline__ void operator()(const accv (&acc)[2][2][4][2], const pg8::Unit& u, int wr, int wc, int fr, int fq) const {
#pragma unroll
        for (int ai = 0; ai < 2; ++ai)
#pragma unroll
            for (int m = 0; m < 4; ++m) {
                const int row = EPI_ROW(u, ai, m); const float inv = inv_from_ss(ss, row, fq);
#pragma unroll
                for (int bj = 0; bj < 2; ++bj) { const accv v0 = acc[ai][bj][m][0] * inv, v1 = acc[ai][bj][m][1] * inv;
                    *(v4u*)(SG + (size_t)row * D + u.pn * 256 + EPI_COL(bj)) = pack8(silu4(v0), silu4(v1)); }
            }
    }
};
struct EpiChanDft {
    static constexpr bool PERM = true;
    bf16* Z; const float* ss;
    __device__ __forceinline__ void operator()(const accv (&acc)[2][2][4][2], const pg8::Unit& u, int wr, int wc, int fr, int fq) const {
        const int g = u.pn >> 1, ri = u.pn & 1;
#pragma unroll
        for (int ai = 0; ai < 2; ++ai)
#pragma unroll
            for (int m = 0; m < 4; ++m) {
                const int row = EPI_ROW(u, ai, m); const float inv = inv_from_ss(ss, row, fq);
#pragma unroll
                for (int bj = 0; bj < 2; ++bj) { const accv v0 = acc[ai][bj][m][0] * inv, v1 = acc[ai][bj][m][1] * inv;
                    *(v4u*)(Z + (size_t)row * 2048 + ri * 1024 + g * 256 + EPI_COL(bj)) = pack8(v0, v1); }
            }
    }
};

constexpr int ATT_KROW = 66;
__device__ __forceinline__ void attn_naive(Frame& F) {
    const bf16* Q = (const bf16*)(F.ws + WS_Q); const bf16* Kb = (const bf16*)(F.ws + WS_K); const bf16* Vb = (const bf16*)(F.ws + WS_V);
    const bf16* SG = (const bf16*)(F.ws + WS_SG); bf16* OG = (bf16*)(F.ws + WS_XB);
    const float* biasT = (const float*)(F.ws + WS_TAB + TAB_BIAS);
    LAS unsigned short* Kl = (LAS unsigned short*)(F.lds); LAS unsigned short* Vl = Kl + 384 * ATT_KROW;
    const int nunits = (TT / 128) * NKV;
    for (int un = F.vcu; un < nunits; un += F.G) {
        const int blk = un >> 2, kvh = un & 3; const int row0 = blk * 128;
        int sq = 0; for (int s = 0; s < NSEQ; ++s) if (row0 >= seq_base(s)) sq = s;
        const int sb = seq_base(sq), sl = seq_len(sq), p0 = row0 - sb;
        __syncthreads();
        for (int e = F.tid; e < 384 * 8; e += NTHR) {
            const int j = e >> 3, c = e & 7; const int pos = p0 - 128 + j;
            v4u kv = (v4u){0u, 0u, 0u, 0u}, vv = kv;
            if (pos >= 0 && pos < sl) { kv = *(const v4u*)(Kb + (size_t)(sb + pos) * KVW + kvh * 64 + c * 8); vv = *(const v4u*)(Vb + (size_t)(sb + pos) * KVW + kvh * 64 + c * 8); }
            LAS unsigned* kd = (LAS unsigned*)(Kl + j * ATT_KROW + c * 8); kd[0] = kv.x; kd[1] = kv.y; kd[2] = kv.z; kd[3] = kv.w;
            LAS unsigned* vd = (LAS unsigned*)(Vl + j * ATT_KROW + c * 8); vd[0] = vv.x; vd[1] = vv.y; vd[2] = vv.z; vd[3] = vv.w;
        }
        __syncthreads();
        const int hl = F.tid >> 7, ql = F.tid & 127, h = kvh * 4 + hl, row = row0 + ql, pos = p0 + ql;
        float qv[64];
#pragma unroll
        for (int c = 0; c < 8; ++c) { const v4u w = *(const v4u*)(Q + (size_t)row * D + h * 64 + c * 8);
            qv[c * 8 + 0] = bflo(w.x); qv[c * 8 + 1] = bfhi(w.x); qv[c * 8 + 2] = bflo(w.y); qv[c * 8 + 3] = bfhi(w.y); qv[c * 8 + 4] = bflo(w.z); qv[c * 8 + 5] = bfhi(w.z); qv[c * 8 + 6] = bflo(w.w); qv[c * 8 + 7] = bfhi(w.w); }
        float mx = biasT[16 * 272 + h], l = 1.0f; float o[64];
#pragma unroll
        for (int d = 0; d < 64; ++d) o[d] = 0.f;
        for (int rel = -128; rel <= 128; ++rel) {
            const int kp = pos + rel; if (kp < 0 || kp >= sl) continue;
            const int j = ql + rel + 128;
            const LAS unsigned* kr = (const LAS unsigned*)(Kl + j * ATT_KROW);
            float s = 0.f;
#pragma unroll
            for (int c = 0; c < 32; ++c) { const unsigned w = kr[c]; s += qv[2 * c] * bflo(w) + qv[2 * c + 1] * bfhi(w); }
            s += biasT[h * 272 + rel + 128];
            const float mn = fmaxf(mx, s), sc = __builtin_amdgcn_exp2f(mx - mn), p = __builtin_amdgcn_exp2f(s - mn);
            l = l * sc + p; mx = mn;
            const LAS unsigned* vr = (const LAS unsigned*)(Vl + j * ATT_KROW);
#pragma unroll
            for (int c = 0; c < 32; ++c) { const unsigned w = vr[c]; o[2 * c] = o[2 * c] * sc + p * bflo(w); o[2 * c + 1] = o[2 * c + 1] * sc + p * bfhi(w); }
        }
        const float il = 1.0f / l;
#pragma unroll
        for (int c = 0; c < 8; ++c) { const v4u g = *(const v4u*)(SG + (size_t)row * D + h * 64 + c * 8); v4u w;
            w.x = pk2(o[c * 8 + 0] * il * bflo(g.x), o[c * 8 + 1] * il * bfhi(g.x)); w.y = pk2(o[c * 8 + 2] * il * bflo(g.y), o[c * 8 + 3] * il * bfhi(g.y));
            w.z = pk2(o[c * 8 + 4] * il * bflo(g.z), o[c * 8 + 5] * il * bfhi(g.z)); w.w = pk2(o[c * 8 + 6] * il * bflo(g.w), o[c * 8 + 7] * il * bfhi(g.w));
            *(v4u*)(OG + (size_t)row * D + h * 64 + c * 8) = w; }
    }
}

template <int NS, int MROWS>
__device__ __forceinline__ void dft_tile_naive(Frame& F, const bf16* A, const bf16* ZY, size_t rowbase, size_t rstride, int cb, float (&acc)[MROWS / 8]) {
    constexpr int KK = 2 * NS, MPT = MROWS / 8;
    LAS float* Bl = (LAS float*)(F.lds);
    __syncthreads();
    for (int e = F.tid; e < KK * 8; e += NTHR) {
        const int k = e >> 3, c = e & 7, ri = k / NS, s = k % NS;
        const v4u w = *(const v4u*)(ZY + (rowbase + (size_t)s * rstride) * 2048 + ri * 1024 + cb * 64 + c * 8);
        LAS float* d = Bl + k * 64 + c * 8;
        d[0] = bflo(w.x); d[1] = bfhi(w.x); d[2] = bflo(w.y); d[3] = bfhi(w.y); d[4] = bflo(w.z); d[5] = bfhi(w.z); d[6] = bflo(w.w); d[7] = bfhi(w.w);
    }
    __syncthreads();
    const int n = F.tid & 63, mg = __builtin_amdgcn_readfirstlane(F.tid >> 6);
#pragma unroll
    for (int i = 0; i < MPT; ++i) acc[i] = 0.f;
    for (int k = 0; k < KK; ++k) {
        const float b = Bl[k * 64 + n];
#pragma unroll
        for (int i = 0; i < MPT; ++i) acc[i] += bf2f(A[(mg * MPT + i) * KK + k]) * b;
    }
    __syncthreads();
}
__device__ __forceinline__ void stage1_naive(Frame& F) {
    bf16* ZY = (bf16*)(F.ws + WS_ZY);
    const bf16* a1p = (const bf16*)(F.ws + WS_TAB + TAB_A1P); const bf16* a1s = (const bf16*)(F.ws + WS_TAB + TAB_A1S);
    const int NU = 4096 + 8192;
    for (int un = F.vcu; un < NU; un += F.G) {
        const int n = F.tid & 63, mg = F.tid >> 6;
        if (un < 4096) {
            const int sq = un >> 11, s2 = (un >> 4) & 127, cb = un & 15; const size_t base = (size_t)seq_base(sq);
            float acc[32];
            dft_tile_naive<128, 256>(F, a1p, ZY, base + s2, 128, cb, acc);
#pragma unroll
            for (int i = 0; i < 32; ++i) if (((i >> 3) & 1) == 0) {
                const int k1 = 16 * mg + (i & 7) + 8 * (i >> 4); const float yr = acc[i], yi = acc[i + 8];
                const int t = (k1 * s2) & 16383; float sn, cs; sincospif((float)t * (1.0f / 8192.0f), &sn, &cs);
                const size_t orow = base + (size_t)k1 * 128 + s2;
                ZY[orow * 2048 + cb * 64 + n] = (bf16)f2bf(yr * cs + yi * sn);
                ZY[orow * 2048 + 1024 + cb * 64 + n] = (bf16)f2bf(yi * cs - yr * sn);
            }
        } else {
            const int v = un - 4096; const int sq = 2 + (v >> 11), s2 = (v >> 4) & 127, cb = v & 15; const size_t base = (size_t)seq_base(sq);
            float acc[8];
            dft_tile_naive<32, 64>(F, a1s, ZY, base + s2, 128, cb, acc);
            const int m0 = mg * 8; const int w = m0 >> 5, j0 = m0 & 31;
            const int part = (j0 >> 3) & 1;
            LAS float* X = (LAS float*)(F.lds);
#pragma unroll
            for (int i = 0; i < 8; ++i) X[(m0 + i) * 64 + n] = acc[i];
            __syncthreads();
            if (part == 0) {
#pragma unroll
                for (int i = 0; i < 8; ++i) {
                    const int k1 = 16 * w + i + 8 * (j0 >> 4); const float yr = acc[i], yi = X[(m0 + 8 + i) * 64 + n];
                    const int t = (k1 * s2) & 4095; float sn, cs; sincospif((float)t * (1.0f / 2048.0f), &sn, &cs);
                    const size_t orow = base + (size_t)k1 * 128 + s2;
                    ZY[orow * 2048 + cb * 64 + n] = (bf16)f2bf(yr * cs + yi * sn);
                    ZY[orow * 2048 + 1024 + cb * 64 + n] = (bf16)f2bf(yi * cs - yr * sn);
                }
            }
            __syncthreads();
        }
    }
}
__device__ __forceinline__ void stage2_naive(Frame& F) {
    const bf16* ZY = (const bf16*)(F.ws + WS_ZY); const bf16* a2 = (const bf16*)(F.ws + WS_TAB + TAB_A2);
    const bf16* SG = (const bf16*)(F.ws + WS_SG); bf16* U = (bf16*)(F.ws + WS_U);
    const int NU = 4096 + 2048;
    for (int un = F.vcu; un < NU; un += F.G) {
        int sq, k1, cb, n1;
        if (un < 4096) { sq = un >> 11; k1 = (un >> 4) & 127; cb = un & 15; n1 = 128; }
        else { const int v = un - 4096; sq = 2 + (v >> 9); k1 = (v >> 4) & 31; cb = v & 15; n1 = 32; }
        const size_t base = (size_t)seq_base(sq);
        float acc[16];
        dft_tile_naive<128, 128>(F, a2, ZY, base + (size_t)k1 * 128, 1, cb, acc);
        const int n = F.tid & 63, mg = F.tid >> 6;
#pragma unroll
        for (int i = 0; i < 16; ++i) {
            const int k2 = mg * 16 + i; const size_t tok = base + k1 + (size_t)n1 * k2;
            const float g = bf2f(SG[tok * D + cb * 64 + n]);
            U[tok * D + cb * 64 + n] = (bf16)f2bf(acc[i] * g);
        }
    }
}

typedef short bf16x8 __attribute__((ext_vector_type(8)));
typedef short s16x4 __attribute__((ext_vector_type(4)));
typedef float f32x16 __attribute__((ext_vector_type(16)));
typedef __attribute__((address_space(3))) const char* lds_cptr;
__device__ __forceinline__ s16x4 vtr(lds_cptr p) { return __builtin_bit_cast(s16x4, __builtin_amdgcn_ds_read_tr16_b64_v4i16((__attribute__((address_space(3))) s16x4*)p)); }
__device__ __forceinline__ float swap_max(float m) { auto rr = __builtin_amdgcn_permlane32_swap(__float_as_uint(m), __float_as_uint(m), false, false); return fmaxf(__uint_as_float(rr[0]), __uint_as_float(rr[1])); }
__device__ __forceinline__ float swap_sum(float m) { auto rr = __builtin_amdgcn_permlane32_swap(__float_as_uint(m), __float_as_uint(m), false, false); return __uint_as_float(rr[0]) + __uint_as_float(rr[1]); }
__device__ __forceinline__ int crow(int r, int hi) { return (r & 3) + 8 * (r >> 2) + 4 * hi; }

template <int KK, int CB, int MB, int NBW>
struct DftCore {
    static constexpr int NKS = KK / 16, NCH = CB / 32, TILE_BYTES = KK * CB * 2, CPR = CB / 8, CHUNKS = KK * CPR, CPT = CHUNKS / NTHR, NS = KK / 2;
    static_assert(CHUNKS % NTHR == 0 && MB * 32 * 1 <= 256 && (8 / MB) * NBW * 32 == CB, "DftCore geometry");
    bf16x8 af[NKS];
    int mb, nq;
    __device__ __forceinline__ void init(const bf16* A, int wave, int lane) {
        mb = wave % MB; nq = wave / MB;
#pragma unroll
        for (int ks = 0; ks < NKS; ++ks) af[ks] = *(const bf16x8*)(A + (size_t)(32 * mb + (lane & 31)) * KK + ks * 16 + 8 * (lane >> 5));
    }
    __device__ __forceinline__ void issue(v4u (&regs)[CPT], const bf16* ZY, size_t rowbase, size_t rstride, int colbase, int tid) const {
#pragma unroll
        for (int i = 0; i < CPT; ++i) { const int e = tid + i * NTHR, k = e / CPR, c8 = e % CPR, ri = k / NS, s = k % NS;
            regs[i] = *(const v4u*)(ZY + (rowbase + (size_t)s * rstride) * 2048 + ri * 1024 + colbase + c8 * 8); }
    }
    __device__ __forceinline__ void write(const v4u (&regs)[CPT], LAS unsigned char* buf, int tid) const {
#pragma unroll
        for (int i = 0; i < CPT; ++i) { const int e = tid + i * NTHR, k = e / CPR, c8 = e % CPR;
            *(LAS v4u*)(buf + ((k >> 4) * NCH + (c8 >> 2)) * 1024 + (k & 15) * 64 + (c8 & 3) * 16) = regs[i]; }
    }
    __device__ __forceinline__ void compute(f32x16 (&acc)[NBW], LAS unsigned char* buf, int lane) const {
        const int hh = lane >> 5, g = (lane >> 4) & 1, i16 = lane & 15, q = i16 >> 2, p = i16 & 3;
        const lds_cptr base = (lds_cptr)buf + (8 * hh + q) * 64 + (16 * g + 4 * p) * 2;
#pragma unroll
        for (int nbi = 0; nbi < NBW; ++nbi) acc[nbi] = f32x16{};
#pragma unroll
        for (int ks = 0; ks < NKS; ++ks)
#pragma unroll
            for (int nbi = 0; nbi < NBW; ++nbi) {
                const lds_cptr a = base + (ks * NCH + nq * NBW + nbi) * 1024;
                const s16x4 t0 = vtr(a), t1 = vtr(a + 256);
                const bf16x8 b = (bf16x8){t0[0], t0[1], t0[2], t0[3], t1[0], t1[1], t1[2], t1[3]};
                acc[nbi] = __builtin_amdgcn_mfma_f32_32x32x16_bf16(af[ks], b, acc[nbi], 0, 0, 0);
            }
    }
};

constexpr int DFT_BUF0 = 0, DFT_BUF1 = 32768, DFT_STG = 65536;

template <bool PROMPT>
__device__ __forceinline__ void stage1_mfma(Frame& F) {
    constexpr int KK = PROMPT ? 256 : 64, CB = PROMPT ? 64 : 128, MB = PROMPT ? 8 : 2, NBW = PROMPT ? 2 : 1, NCB = 1024 / CB;
    constexpr int SLEN = PROMPT ? 16384 : 4096;
    typedef DftCore<KK, CB, MB, NBW> Core;
    bf16* ZY = (bf16*)(F.ws + WS_ZY);
    Core C; C.init((const bf16*)(F.ws + WS_TAB + (PROMPT ? TAB_A1P : TAB_A1S)), F.wave, F.lane);
    constexpr int NU = (PROMPT ? 2 : 4) * 128 * NCB;
    const int hh = F.lane >> 5, r32 = F.lane & 31;
    v4u regs[Core::CPT];
    int un = F.vcu; int it = 0;
#define S1_DECODE(u, sq, s2, cb) const int sq = (PROMPT ? 0 : 2) + (u) / (128 * NCB), s2 = ((u) / NCB) & 127, cb = (u) % NCB
    __syncthreads();
    if (un < NU) { S1_DECODE(un, sq, s2, cb); C.issue(regs, ZY, (size_t)seq_base(sq) + s2, 128, cb * CB, F.tid); C.write(regs, F.lds + DFT_BUF0, F.tid); }
    __syncthreads();
    for (; un < NU; un += F.G, ++it) {
        S1_DECODE(un, sq, s2, cb);
        const int nun = un + F.G;
        if (nun < NU) { S1_DECODE(nun, nsq, ns2, ncb); C.issue(regs, ZY, (size_t)seq_base(nsq) + ns2, 128, ncb * CB, F.tid); }
        LAS unsigned char* buf = F.lds + ((it & 1) ? DFT_BUF1 : DFT_BUF0);
        f32x16 acc[NBW];
        C.compute(acc, buf, F.lane);
        LAS unsigned short* stg = (LAS unsigned short*)(F.lds + DFT_STG);
#pragma unroll
        for (int t = 0; t < 8; ++t) {
            const int r = (t & 3) + 8 * (t >> 2);
            const int k1 = 16 * C.mb + (t & 3) + 4 * hh + 8 * (t >> 2);
            const float fr = (float)((k1 * s2) & (SLEN - 1)) * (1.0f / SLEN);
            const float cs = __builtin_amdgcn_cosf(fr), sn = __builtin_amdgcn_sinf(fr);
#pragma unroll
            for (int nbi = 0; nbi < NBW; ++nbi) {
                const float re = acc[nbi][r], im = acc[nbi][r + 4];
                const int col = (C.nq * NBW + nbi) * 32 + r32;
                stg[(2 * k1) * CB + col] = (unsigned short)f2bf(re * cs + im * sn);
                stg[(2 * k1 + 1) * CB + col] = (unsigned short)f2bf(im * cs - re * sn);
            }
        }
        LDS_WAIT(); __syncthreads();
        {
            constexpr int CPRW = CB / 8, NCHK = 32 * MB * CPRW / NTHR;
            const size_t base = (size_t)seq_base(sq);
#pragma unroll
            for (int i = 0; i < NCHK; ++i) { const int idx = F.tid + i * NTHR, rl = idx / CPRW, ch = idx % CPRW, k1 = rl >> 1, part = rl & 1;
                const v4u v = *(const LAS v4u*)((LAS unsigned char*)stg + (size_t)rl * CB * 2 + ch * 16);
                *(v4u*)(ZY + (base + (size_t)k1 * 128 + s2) * 2048 + part * 1024 + cb * CB + ch * 8) = v; }
        }
        if (nun < NU) C.write(regs, F.lds + ((it & 1) ? DFT_BUF0 : DFT_BUF1), F.tid);
        LDS_WAIT(); __syncthreads();
    }
#undef S1_DECODE
}

__device__ __forceinline__ void stage2_mfma(Frame& F) {
    typedef DftCore<256, 64, 4, 1> Core;
    const bf16* ZY = (const bf16*)(F.ws + WS_ZY); const bf16* SG = (const bf16*)(F.ws + WS_SG); bf16* U = (bf16*)(F.ws + WS_U);
    Core C; C.init((const bf16*)(F.ws + WS_TAB + TAB_A2), F.wave, F.lane);
    constexpr int NU = 4096 + 2048;
    const int hh = F.lane >> 5, r32 = F.lane & 31;
    v4u regs[Core::CPT];
    int un = F.vcu; int it = 0;
#define S2_DECODE(u, sq, k1, cb, n1) int sq, k1, cb, n1; if ((u) < 4096) { sq = (u) >> 11; k1 = ((u) >> 4) & 127; cb = (u) & 15; n1 = 128; } else { const int v_ = (u) - 4096; sq = 2 + (v_ >> 9); k1 = (v_ >> 4) & 31; cb = v_ & 15; n1 = 32; }
    __syncthreads();
    if (un < NU) { S2_DECODE(un, sq, k1, cb, n1); (void)n1; C.issue(regs, ZY, (size_t)seq_base(sq) + (size_t)k1 * 128, 1, cb * 64, F.tid); C.write(regs, F.lds + DFT_BUF0, F.tid); }
    __syncthreads();
    for (; un < NU; un += F.G, ++it) {
        S2_DECODE(un, sq, k1, cb, n1);
        const int nun = un + F.G;
        if (nun < NU) { S2_DECODE(nun, nsq, nk1, ncb, nn1); (void)nn1; C.issue(regs, ZY, (size_t)seq_base(nsq) + (size_t)nk1 * 128, 1, ncb * 64, F.tid); }
        LAS unsigned char* buf = F.lds + ((it & 1) ? DFT_BUF1 : DFT_BUF0);
        f32x16 acc[1];
        C.compute(acc, buf, F.lane);
        LAS float* stg = (LAS float*)(F.lds + DFT_STG);
#pragma unroll
        for (int r = 0; r < 16; ++r) stg[(32 * C.mb + crow(r, hh)) * 64 + C.nq * 32 + r32] = acc[0][r];
        LDS_WAIT(); __syncthreads();
        {
            const size_t base = (size_t)seq_base(sq);
#pragma unroll
            for (int i = 0; i < 2; ++i) { const int idx = F.tid + i * NTHR, k2 = idx >> 3, ch = idx & 7;
                const size_t tok = base + k1 + (size_t)n1 * k2;
                const v4u g = *(const v4u*)(SG + tok * D + cb * 64 + ch * 8);
                const f32x4 f0 = *(const LAS f32x4*)(stg + k2 * 64 + ch * 8), f1 = *(const LAS f32x4*)(stg + k2 * 64 + ch * 8 + 4);
                v4u w; w.x = pk2(f0[0] * bflo(g.x), f0[1] * bfhi(g.x)); w.y = pk2(f0[2] * bflo(g.y), f0[3] * bfhi(g.y));
                w.z = pk2(f1[0] * bflo(g.z), f1[1] * bfhi(g.z)); w.w = pk2(f1[2] * bflo(g.w), f1[3] * bfhi(g.w));
                *(v4u*)(U + tok * D + cb * 64 + ch * 8) = w; }
        }
        if (nun < NU) C.write(regs, F.lds + ((it & 1) ? DFT_BUF0 : DFT_BUF1), F.tid);
        LDS_WAIT(); __syncthreads();
    }
#undef S2_DECODE
}

constexpr int AT_K = 0, AT_KSTRIDE = 385 * 16, AT_V = 49664, AT_BIAS = AT_V + 49152, AT_STG = AT_BIAS + 8192, AT_WSF = AT_STG + 32768, AT_END = AT_WSF + 8 * 256;
static_assert(8 * AT_KSTRIDE <= AT_V && AT_END <= RING_BYTES, "attention LDS map");
#ifndef ATT_THR
#define ATT_THR 8.0f
#endif
__device__ __forceinline__ void attn_mfma(Frame& F) {
    const bf16* Q = (const bf16*)(F.ws + WS_Q); const bf16* Kb = (const bf16*)(F.ws + WS_K); const bf16* Vb = (const bf16*)(F.ws + WS_V);
    const bf16* SG = (const bf16*)(F.ws + WS_SG); bf16* OG = (bf16*)(F.ws + WS_XB);
    const float* biasT = (const float*)(F.ws + WS_TAB + TAB_BIAS);
    LAS unsigned char* Kl = F.lds + AT_K; LAS unsigned char* Vl = F.lds + AT_V; LAS float* Bl = (LAS float*)(F.lds + AT_BIAS);
    LAS unsigned short* stg = (LAS unsigned short*)(F.lds + AT_STG + F.wave * 4096); LAS float* wsf = (LAS float*)(F.lds + AT_WSF + F.wave * 256);
    const int lane = F.lane, hh = lane >> 5, r32 = lane & 31, g = (lane >> 4) & 1, i16 = lane & 15, tq = i16 >> 2, tp = i16 & 3;
    const int nunits = (TT / 128) * NKV;
    const int hl = F.wave >> 1, qs0 = 2 * (F.wave & 1);
    v4u kreg[6], vreg[6]; bf16x8 qr[2][4];
#define AT_GEOM(u, row0, kvh, sb, sl, p0) const int row0 = ((u) >> 2) * 128, kvh = (u) & 3; int sq_ = 0; for (int s_ = 0; s_ < NSEQ; ++s_) if (row0 >= seq_base(s_)) sq_ = s_; \
        const int sb = seq_base(sq_), sl = seq_len(sq_), p0 = row0 - sb
#define AT_ISSUE_KV(u) do { AT_GEOM(u, row0_, kvh_, sb_, sl_, p0_); _Pragma("unroll") for (int i = 0; i < 6; ++i) { const int e = F.tid + i * NTHR, j = e >> 3, c = e & 7; const int pos = p0_ - 128 + j; \
            kreg[i] = (v4u){0u, 0u, 0u, 0u}; vreg[i] = kreg[i]; \
            if (pos >= 0 && pos < sl_) { kreg[i] = *(const v4u*)(Kb + (size_t)(sb_ + pos) * KVW + kvh_ * 64 + c * 8); vreg[i] = *(const v4u*)(Vb + (size_t)(sb_ + pos) * KVW + kvh_ * 64 + c * 8); } } } while (0)
#define AT_ISSUE_Q(u, sbi) do { const int row0_ = ((u) >> 2) * 128, h_ = ((u) & 3) * 4 + hl; _Pragma("unroll") for (int ds = 0; ds < 4; ++ds) \
            qr[sbi][ds] = *(const bf16x8*)(Q + (size_t)(row0_ + (qs0 + (sbi)) * 32 + r32) * D + h_ * 64 + ds * 16 + 8 * hh); } while (0)
    int un = F.vcu;
    if (un < nunits) { AT_ISSUE_KV(un); AT_ISSUE_Q(un, 0); AT_ISSUE_Q(un, 1); }
    for (; un < nunits; un += F.G) {
        AT_GEOM(un, row0, kvh, sb, sl, p0); (void)sb;
        const int jlo = p0 >= 128 ? 0 : 128 - p0, jhi = (sl - p0 + 128) < 384 ? (sl - p0 + 128) : 384;
        const bool edge = (jlo > 0) || (jhi < 384);
        const int nun = un + F.G; const bool has_next = nun < nunits;
        __syncthreads();
#pragma unroll
        for (int i = 0; i < 6; ++i) {
            const int e = F.tid + i * NTHR, j = e >> 3, c = e & 7;
            *(LAS v4u*)(Kl + c * AT_KSTRIDE + j * 16) = kreg[i];
            *(LAS v4u*)(Vl + ((j >> 4) * 2 + (c >> 2)) * 1024 + (j & 15) * 64 + (c & 3) * 16) = vreg[i];
        }
#pragma unroll
        for (int i = 0; i < 4; ++i) { const int e = F.tid + i * NTHR, hl2 = e >> 9, idx = (e & 511) - 128;
            Bl[e] = (idx >= 0 && idx <= 256) ? biasT[(kvh * 4 + hl2) * 272 + idx] : -INFINITY; }
        LDS_WAIT(); __syncthreads();
        if (has_next) AT_ISSUE_KV(nun);
        const int h = kvh * 4 + hl;
        const float sinkv = biasT[16 * 272 + h];
#pragma unroll
        for (int sbi = 0; sbi < 2; ++sbi) {
            const int qs = qs0 + sbi, qo = qs * 32;
            float mref = sinkv, lpart = hh == 0 ? 1.0f : 0.0f;
            f32x16 o[2]; o[0] = f32x16{}; o[1] = f32x16{};
            const int kt0 = qs >> 1;
            for (int t = 0; t < 5; ++t) {
                const int jb = 64 * (kt0 + t);
                const LAS float* bb = Bl + hl * 512 + jb - qo - r32 + 128 + 4 * hh;
                f32x16 pA, pB;
#pragma unroll
                for (int r = 0; r < 16; ++r) { const int cr = (r & 3) + 8 * (r >> 2); pA[r] = bb[cr]; pB[r] = bb[32 + cr]; }
#pragma unroll
                for (int ds = 0; ds < 4; ++ds) {
                    const bf16x8 a0 = *(const LAS bf16x8*)(Kl + (2 * ds + hh) * AT_KSTRIDE + (jb + r32) * 16);
                    const bf16x8 a1 = *(const LAS bf16x8*)(Kl + (2 * ds + hh) * AT_KSTRIDE + (jb + 32 + r32) * 16);
                    pA = __builtin_amdgcn_mfma_f32_32x32x16_bf16(a0, qr[sbi][ds], pA, 0, 0, 0);
                    pB = __builtin_amdgcn_mfma_f32_32x32x16_bf16(a1, qr[sbi][ds], pB, 0, 0, 0);
                }
                if (edge) {
#pragma unroll
                    for (int r = 0; r < 16; ++r) { const int j = jb + crow(r, hh); if (j < jlo || j >= jhi) pA[r] = -INFINITY; if (j + 32 < jlo || j + 32 >= jhi) pB[r] = -INFINITY; }
                }
                float rm = fmaxf(fmaxf(pA[0], pB[0]), fmaxf(pA[1], pB[1]));
#pragma unroll
                for (int r = 2; r < 16; r += 2) rm = fmaxf(fmaxf(rm, pA[r]), fmaxf(fmaxf(pB[r], pA[r + 1]), pB[r + 1]));
                rm = swap_max(rm);
                if (__any(rm > mref + ATT_THR)) {
                    const float mn = fmaxf(mref, rm), alpha = __builtin_amdgcn_exp2f(mref - mn);
                    lpart *= alpha; mref = mn;
                    if (hh == 0) wsf[r32] = alpha;
                    LDS_WAIT();
#pragma unroll
                    for (int r = 0; r < 16; ++r) { const float a = wsf[crow(r, hh)]; o[0][r] *= a; o[1][r] *= a; }
                    LDS_WAIT();
                }
                float ls = 0.f;
#pragma unroll
                for (int r = 0; r < 16; ++r) { pA[r] = __builtin_amdgcn_exp2f(pA[r] - mref); pB[r] = __builtin_amdgcn_exp2f(pB[r] - mref); ls += pA[r] + pB[r]; }
                lpart += ls;
                v4u pw[4];
                pw[0] = (v4u){cvt_pk_bf16(pA[0], pA[1]), cvt_pk_bf16(pA[2], pA[3]), cvt_pk_bf16(pA[4], pA[5]), cvt_pk_bf16(pA[6], pA[7])};
                pw[1] = (v4u){cvt_pk_bf16(pA[8], pA[9]), cvt_pk_bf16(pA[10], pA[11]), cvt_pk_bf16(pA[12], pA[13]), cvt_pk_bf16(pA[14], pA[15])};
                pw[2] = (v4u){cvt_pk_bf16(pB[0], pB[1]), cvt_pk_bf16(pB[2], pB[3]), cvt_pk_bf16(pB[4], pB[5]), cvt_pk_bf16(pB[6], pB[7])};
                pw[3] = (v4u){cvt_pk_bf16(pB[8], pB[9]), cvt_pk_bf16(pB[10], pB[11]), cvt_pk_bf16(pB[12], pB[13]), cvt_pk_bf16(pB[14], pB[15])};
                const lds_cptr vb = (lds_cptr)Vl + (jb >> 4) * 2048 + (4 * hh + tq) * 64 + (16 * g + 4 * tp) * 2;
#pragma unroll
                for (int ks = 0; ks < 4; ++ks)
#pragma unroll
                    for (int dh = 0; dh < 2; ++dh) {
                        const lds_cptr a = vb + ks * 2048 + dh * 1024;
                        const s16x4 t0 = vtr(a), t1 = vtr(a + 512);
                        const bf16x8 vf = (bf16x8){t0[0], t0[1], t0[2], t0[3], t1[0], t1[1], t1[2], t1[3]};
                        o[dh] = __builtin_amdgcn_mfma_f32_32x32x16_bf16(__builtin_bit_cast(bf16x8, pw[ks]), vf, o[dh], 0, 0, 0);
                    }
            }
            v4u sgr[4];
#pragma unroll
            for (int i = 0; i < 4; ++i) sgr[i] = *(const v4u*)(SG + (size_t)(row0 + qo + i * 8 + (lane >> 3)) * D + h * 64 + (lane & 7) * 8);
            if (has_next) AT_ISSUE_Q(nun, sbi);
            const float ltot = swap_sum(lpart);
            if (hh == 0) wsf[32 + r32] = ltot;
            LDS_WAIT();
#pragma unroll
            for (int r = 0; r < 16; ++r) { const float rl = 1.0f / wsf[32 + crow(r, hh)];
                stg[crow(r, hh) * 64 + r32] = (unsigned short)f2bf(o[0][r] * rl); stg[crow(r, hh) * 64 + 32 + r32] = (unsigned short)f2bf(o[1][r] * rl); }
            LDS_WAIT();
#pragma unroll
            for (int i = 0; i < 4; ++i) { const int row = i * 8 + (lane >> 3), ch = lane & 7;
                const v4u v = *(const LAS v4u*)((LAS unsigned char*)stg + row * 128 + ch * 16);
                const size_t off = (size_t)(row0 + qo + row) * D + h * 64 + ch * 8;
                const v4u gt = sgr[i]; v4u w;
                w.x = pk2(bflo(v.x) * bflo(gt.x), bfhi(v.x) * bfhi(gt.x)); w.y = pk2(bflo(v.y) * bflo(gt.y), bfhi(v.y) * bfhi(gt.y));
                w.z = pk2(bflo(v.z) * bflo(gt.z), bfhi(v.z) * bfhi(gt.z)); w.w = pk2(bflo(v.w) * bflo(gt.w), bfhi(v.w) * bfhi(gt.w));
                *(v4u*)(OG + off) = w; }
            LDS_WAIT();
        }
    }
#undef AT_GEOM
#undef AT_ISSUE_KV
#undef AT_ISSUE_Q
}

__device__ __forceinline__ void final_norm(Frame& F) {
    const float* ss = (const float*)(F.ws + WS_SS2);
    const int gw = F.vcu * NWAVES + F.wave, NGW = F.G * NWAVES;
    for (int m = gw; m < TT; m += NGW) {
        float s = F.lane < 16 ? ss[(size_t)m * 16 + F.lane] : 0.f; s = wave_sum(s);
        const float inv = 1.0f / sqrtf(s * (1.0f / D) + RMS_EPS);
        GAS f32x4* xr = (GAS f32x4*)(F.out + (size_t)m * D) + F.lane; const GAS f32x4* gr = (const GAS f32x4*)F.gf + F.lane;
#pragma unroll
        for (int j = 0; j < 4; ++j) { const f32x4 v = xr[64 * j], g = gr[64 * j]; xr[64 * j] = v * inv * g; }
    }
}

struct Args { const float* in[11]; float* out; unsigned char* ws; int ph_lo, ph_hi; };
__global__ void __launch_bounds__(NTHR, 2) mk_fwd(Args args) {
    extern __shared__ __attribute__((aligned(16))) unsigned char lds[];
    Frame F;
    F.lds = (LAS unsigned char*)lds;
    F.MISC = (volatile LAS unsigned*)(F.lds + MISC_OFF);
    F.tid = threadIdx.x; F.lane = F.tid & 63; F.wave = __builtin_amdgcn_readfirstlane(F.tid >> 6);
    F.G = gridDim.x; { const int bx = blockIdx.x; F.vcu = (F.G % 8 == 0) ? (bx % 8) * (F.G / 8) + bx / 8 : bx; }
    F.ws = args.ws; F.ctl = (gu32*)(args.ws + WS_CTL); F.out = args.out;
    F.xp = args.in[0]; F.xs = args.in[1]; F.relb = args.in[2]; F.g1 = args.in[3]; F.win = args.in[4]; F.wo = args.in[5]; F.sink = args.in[6];
    F.g2 = args.in[7]; F.wg = args.in[8]; F.wo2 = args.in[9]; F.gf = args.in[10];
    for (int u = F.tid; u < (LDS_BYTES - LDSCTL_OFF) / 4; u += NTHR) ((LAS unsigned*)(F.lds + LDSCTL_OFF))[u] = 0u;
    __syncthreads();
    const int lo = args.ph_lo, hi = args.ph_hi;
    XcdBarrier bar; bar.bar = (unsigned*)(F.ctl + CW_BAR); bar.x = 0; bar.st = nullptr;
    if (hi - lo > 1) bar = xcd_barrier_post((unsigned*)(F.ctl + CW_BAR), F.MISC + 8);
#define IN(k) (lo <= (k) && (k) < hi)
#define SEAM(k) do { if (IN(k) && IN((k) + 1)) xcd_barrier(bar); } while (0)
    unsigned char* ws = args.ws;
    bf16* XB = (bf16*)(ws + WS_XB); bf16* Qb = (bf16*)(ws + WS_Q); bf16* Kb = (bf16*)(ws + WS_K); bf16* Vb = (bf16*)(ws + WS_V); bf16* SG = (bf16*)(ws + WS_SG);
    bf16* ZY = (bf16*)(ws + WS_ZY);
    float* inv0 = (float*)(ws + WS_TAB + TAB_INV0); float* ss1 = (float*)(ws + WS_SS1); float* ss2 = (float*)(ws + WS_SS2);

    if (IN(0)) REP(0) { p0_prologue(F); } SEAM(0);
    if (IN(1)) REP(1) {
        pg8::Gemm g{XB, (const bf16*)(ws + WS_WIN), TT, INW, D, D, D, 0}; pg8::StaticOrder S; S.init(TT, INW, F.G, (int)blockIdx.x);
        EpiInProj E{Qb, Kb, Vb, SG, inv0};
        pg8::gemm_phase<EpiInProj, pg8::StaticOrder, true>(F.lds + RING_OFF, g, S, E);
    } SEAM(1);
    if (IN(2)) REP(2) { if (USE_MFMA_ATTN) attn_mfma(F); else attn_naive(F); } SEAM(2);
    if (IN(3)) REP(3) {
        pg8::Gemm g{XB, (const bf16*)(ws + WS_WO), TT, D, D, D, D, 0}; pg8::StaticOrder S; S.init(TT, D, F.G, (int)blockIdx.x);
        EpiResid1 E{F.xp, F.xs, Qb, ss1};
        pg8::gemm_phase<EpiResid1, pg8::StaticOrder, true>(F.lds + RING_OFF, g, S, E);
    } SEAM(3);
    if (IN(4)) REP(4) {
        { pg8::Gemm g{Qb, (const bf16*)(ws + WS_WG), TT, D, D, D, D, 0}; pg8::StaticOrder S; S.init(TT, D, F.G, (int)blockIdx.x);
          EpiGate2 E{SG, ss1};
          pg8::gemm_phase<EpiGate2, pg8::StaticOrder, true>(F.lds + RING_OFF, g, S, E); }
        { pg8::Gemm g{Qb, (const bf16*)(ws + WS_WDFT), TT, 2048, 256, D, 256, 2}; pg8::StaticOrder S; S.init(TT, 2048, F.G, (int)blockIdx.x);
          EpiChanDft E{ZY, ss1};
          pg8::gemm_phase<EpiChanDft, pg8::StaticOrder, true>(F.lds + RING_OFF, g, S, E); }
    } SEAM(4);
    if (IN(5)) { if (USE_MFMA_DFT) { stage1_mfma<true>(F); stage1_mfma<false>(F); } else stage1_naive(F); } SEAM(5);
    if (IN(6)) REP(6) { if (USE_MFMA_DFT) stage2_mfma(F); else stage2_naive(F); } SEAM(6);
    if (IN(7)) {
        pg8::Gemm g{(const bf16*)(ws + WS_U), (const bf16*)(ws + WS_WO2), TT, D, D, D, D, 0}; pg8::StaticOrder S; S.init(TT, D, F.G, (int)blockIdx.x);
        EpiResid2 E{Qb, F.out, ss2};
        pg8::gemm_phase<EpiResid2, pg8::StaticOrder, true>(F.lds + RING_OFF, g, S, E);
    } SEAM(7);
    if (IN(8)) { final_norm(F); }
#undef IN
#undef SEAM
}

extern "C" void kernel_launch(void* const* d_in, const int* in_sizes, int n_in, void* d_out, int out_size, void* d_ws, size_t ws_size, hipStream_t stream) {
    static int grid = 0;
    if (grid == 0) {
        if (n_in != 11 || in_sizes[0] != T_PROMPT * D || in_sizes[1] != T_SAMPLE * D || out_size != TT * D || ws_size < WS_END) {
            fprintf(stderr, "kernel_launch: unexpected shapes (n_in %d, in0 %d, in1 %d, out %d, ws %zu); nothing launched\n", n_in, n_in > 0 ? in_sizes[0] : -1, n_in > 1 ? in_sizes[1] : -1, out_size, ws_size); grid = -1; return; }
        int dev = 0, cus = 0, per_cu = 0;
        if (hipGetDevice(&dev) != hipSuccess || hipDeviceGetAttribute(&cus, hipDeviceAttributeMultiprocessorCount, dev) != hipSuccess) { grid = -1; return; }
        if (hipFuncSetAttribute((const void*)mk_fwd, hipFuncAttributeMaxDynamicSharedMemorySize, LDS_BYTES) != hipSuccess) { fprintf(stderr, "kernel_launch: hipFuncSetAttribute failed\n"); grid = -1; return; }
        if (hipOccupancyMaxActiveBlocksPerMultiprocessor(&per_cu, (const void*)mk_fwd, NTHR, LDS_BYTES) != hipSuccess || per_cu < 1) { fprintf(stderr, "kernel_launch: occupancy query says %d blocks per CU\n", per_cu); grid = -1; (void)hipGetLastError(); return; }
        (void)hipGetLastError();
        grid = cus;
    }
    if (grid < 0) return;
    (void)hipMemsetAsync((char*)d_ws + WS_CTL, 0, CTL_ZERO_BYTES, stream);
    Args a{};
    for (int i = 0; i < 11; ++i) a.in[i] = (const float*)d_in[i];
    a.out = (float*)d_out; a.ws = (unsigned char*)d_ws;
#if MK_ONE_LAUNCH
    a.ph_lo = 0; a.ph_hi = NPH;
    hipLaunchKernelGGL(mk_fwd, dim3(grid), dim3(NTHR), LDS_BYTES, stream, a);
#else
    for (int p = 0; p < NPH; ++p) { a.ph_lo = p; a.ph_hi = p + 1; hipLaunchKernelGGL(mk_fwd, dim3(grid), dim3(NTHR), LDS_BYTES, stream, a); }
#endif
}
```
